# Optimizing an MI355X kernel written in HIP

```python
import math
import jax, jax.numpy as jnp
from jax import lax
import numpy as np

D_MODEL = 1024
BATCH = 8
SEQ = 2048
DEPTH = 1

HYENA_WIDTH = D_MODEL
POOL_WIDTH = D_MODEL
HYENA_ORDER = 2
SHORT_CONV = 3
FILTER_EMB = 33
FILTER_HIDDEN = 64
FAST_DECAY_PCT = 0.3
SLOW_DECAY_PCT = 1.5
DECAY_TARGET = 1e-2
MAX_DECAY = math.log(DECAY_TARGET) / FAST_DECAY_PCT
MIN_DECAY = math.log(DECAY_TARGET) / SLOW_DECAY_PCT
POOL_WINDOWS = (2, 4, 8, 16)
POOL_GROUPS = len(POOL_WINDOWS)
POOL_GROUP_WIDTH = POOL_WIDTH // POOL_GROUPS
N_BRANCHES = 2
HY_IN = (HYENA_ORDER + 1) * HYENA_WIDTH
PROJ_COLS = HY_IN + HYENA_WIDTH + 2 * POOL_WIDTH + N_BRANCHES * D_MODEL
NORM_EPS = 1e-6

kernel_name = "hyena_pool_gated_hybrid_encoder"


def rms_norm(x, g):
    xf = x.astype(jnp.float32)
    y = xf * lax.rsqrt(jnp.mean(xf * xf, axis=-1, keepdims=True) + NORM_EPS)
    return (y * g.astype(jnp.float32)).astype(x.dtype)


def centred_short_conv(u, w, b):
    L = u.shape[1]
    half = SHORT_CONV // 2
    up = jnp.pad(u, ((0, 0), (half, half), (0, 0)))
    out = up[:, 0:L] * w[0]
    for k in range(1, SHORT_CONV):
        out = out + up[:, k:k + L] * w[k]
    return out + b


def filter_features(L):
    t = jnp.linspace(0.0, 1.0, L, dtype=jnp.float32)[:, None]
    bands = (FILTER_EMB - 1) // 2
    w = 2.0 * math.pi * jnp.arange(L, dtype=jnp.float32) / L
    f = jnp.linspace(1e-4, bands - 1, bands, dtype=jnp.float32)
    ang = w[:, None] * f[None, :]
    return jnp.concatenate([t, jnp.cos(ang), -jnp.sin(ang)], axis=-1), t


def implicit_filters(L, w1, b1, w2, b2, w3, b3, w4, freq):
    z, t = filter_features(L)
    fr = freq.astype(jnp.float32)
    h = jnp.sin(fr * (z @ w1.astype(jnp.float32) + b1.astype(jnp.float32)))
    h = jnp.sin(fr * (h @ w2.astype(jnp.float32) + b2.astype(jnp.float32)))
    h = jnp.sin(fr * (h @ w3.astype(jnp.float32) + b3.astype(jnp.float32)))
    k = h @ w4.astype(jnp.float32)
    deltas = jnp.abs(jnp.linspace(MIN_DECAY, MAX_DECAY, HYENA_WIDTH, dtype=jnp.float32))
    decay = jnp.exp(-t * deltas[None, :])
    k = k.reshape(L, 2, HYENA_WIDTH) * decay[:, None, :]
    return k[:, 0], k[:, 1]


def bidir_long_conv(u, k_fwd, k_bwd, d_skip):
    B, L, C = u.shape
    n = 2 * L
    k_two = jnp.concatenate([
        k_fwd.at[0].add(k_bwd[0]),
        jnp.zeros((1, C), jnp.float32),
        k_bwd[1:][::-1],
    ], axis=0)
    uf32 = u.astype(jnp.float32)
    u_hat = jnp.fft.rfft(uf32, n=n, axis=1)
    k_hat = jnp.fft.rfft(k_two, n=n, axis=0)
    y = jnp.fft.irfft(u_hat * k_hat[None], n=n, axis=1)[:, :L]
    return (y + uf32 * d_skip.astype(jnp.float32)).astype(u.dtype)


def multiscale_pool_mixer(u, w_grp, b_grp, scale):
    B, L, C = u.shape
    uf = u.astype(jnp.float32)
    csum = jnp.concatenate([jnp.zeros((B, 1, C), jnp.float32), jnp.cumsum(uf, axis=1)], axis=1)
    pos = jnp.arange(L)
    outs = []
    for g, win in enumerate(POOL_WINDOWS):
        sl = slice(g * POOL_GROUP_WIDTH, (g + 1) * POOL_GROUP_WIDTH)
        lo = jnp.clip(pos - win // 2, 0, L)
        hi = jnp.clip(pos + (win - win // 2), 0, L)
        c = csum[:, :, sl]
        s = jnp.take(c, hi, axis=1) - jnp.take(c, lo, axis=1)
        cnt = (hi - lo).astype(jnp.float32)[None, :, None]
        outs.append(s / cnt - uf[:, :, sl])
    pooled = jnp.concatenate(outs, axis=-1).reshape(B, L, POOL_GROUPS, POOL_GROUP_WIDTH).astype(u.dtype)
    y = jnp.einsum('blgc,gcd->blgd', pooled, w_grp).reshape(B, L, C) + b_grp
    return y * scale


def setup_inputs(seed: int = 0) -> dict:
    key = jax.random.key(seed)
    ks = jax.random.split(key, 24)
    f32 = jnp.float32
    n = lambda k, shape, s: jax.random.normal(k, shape, f32) * s
    Dh, Dp, D, Hf = HYENA_WIDTH, POOL_WIDTH, D_MODEL, FILTER_HIDDEN
    return {
        "x": jax.random.normal(ks[0], (BATCH, SEQ, D), f32),
        "g_norm": 1.0 + n(ks[1], (DEPTH, D), 0.05),
        "w_in": n(ks[2], (DEPTH, D, PROJ_COLS), D ** -0.5),
        "b_in": n(ks[3], (DEPTH, PROJ_COLS), 0.02),
        "conv_w": n(ks[4], (DEPTH, SHORT_CONV, HY_IN), SHORT_CONV ** -0.5),
        "conv_b": n(ks[5], (DEPTH, HY_IN), 0.02),
        "filt_w1": n(ks[6], (DEPTH, FILTER_EMB, Hf), FILTER_EMB ** -0.5),
        "filt_b1": n(ks[7], (DEPTH, Hf), 0.1),
        "filt_w2": n(ks[8], (DEPTH, Hf, Hf), Hf ** -0.5),
        "filt_b2": n(ks[9], (DEPTH, Hf), 0.1),
        "filt_w3": n(ks[10], (DEPTH, Hf, Hf), Hf ** -0.5),
        "filt_b3": n(ks[11], (DEPTH, Hf), 0.1),
        "filt_w4": n(ks[12], (DEPTH, Hf, 2 * Dh), 0.05 * Hf ** -0.5),
        "filt_freq": 1.0 + n(ks[13], (DEPTH, Hf), 0.1),
        "hyena_d": n(ks[14], (DEPTH, Dh), 1.0),
        "w_hyena_out": n(ks[15], (DEPTH, Dh, D), Dh ** -0.5),
        "pool_w": n(ks[16], (DEPTH, POOL_GROUPS, POOL_GROUP_WIDTH, POOL_GROUP_WIDTH), POOL_GROUP_WIDTH ** -0.5),
        "pool_b": n(ks[17], (DEPTH, Dp), 0.02),
        "pool_scale": 1.0 + n(ks[18], (DEPTH, Dp), 0.1),
        "w_pool_out": n(ks[19], (DEPTH, Dp, D), Dp ** -0.5),
        "w_out": n(ks[20], (DEPTH, D, D), D ** -0.5),
        "g_final": 1.0 + n(ks[21], (D,), 0.05),
    }


def reference(x, g_norm, w_in, b_in, conv_w, conv_b, filt_w1, filt_b1, filt_w2, filt_b2,
              filt_w3, filt_b3, filt_w4, filt_freq, hyena_d, w_hyena_out, pool_w, pool_b,
              pool_scale, w_pool_out, w_out, g_final):
    B, L, D = x.shape
    Dh, Dp = HYENA_WIDTH, POOL_WIDTH
    o1 = HY_IN
    o2 = o1 + Dh
    o3 = o2 + Dp
    o4 = o3 + Dp
    for l in range(DEPTH):
        h = rms_norm(x, g_norm[l])
        proj = h @ w_in[l] + b_in[l]
        hy_in, hy_z = proj[..., :o1], proj[..., o1:o2]
        pl_in, pl_z = proj[..., o2:o3], proj[..., o3:o4]
        gates = jax.nn.sigmoid(proj[..., o4:].reshape(B, L, N_BRANCHES, D))

        uc = centred_short_conv(hy_in, conv_w[l], conv_b[l])
        x0, x1, v = uc[..., :Dh], uc[..., Dh:2 * Dh], uc[..., 2 * Dh:]
        k_fwd, k_bwd = implicit_filters(L, filt_w1[l], filt_b1[l], filt_w2[l], filt_b2[l],
                                        filt_w3[l], filt_b3[l], filt_w4[l], filt_freq[l])
        v = bidir_long_conv(v * x1, k_fwd, k_bwd, hyena_d[l])
        y_h = v * x0 * jax.nn.silu(hy_z)
        out_h = y_h @ w_hyena_out[l]

        y_p = multiscale_pool_mixer(pl_in, pool_w[l], pool_b[l], pool_scale[l]) * jax.nn.silu(pl_z)
        out_p = y_p @ w_pool_out[l]

        merged = gates[..., 0, :] * out_h + gates[..., 1, :] * out_p
        x = x + merged @ w_out[l]
    return rms_norm(x, g_final)
```

```cpp
#include <hip/hip_runtime.h>
#include <cstdio>
#include <cstdint>

typedef unsigned short bf16;
typedef short bf16x8 __attribute__((ext_vector_type(8)));
typedef float f32x16 __attribute__((ext_vector_type(16)));
typedef float f32x4 __attribute__((ext_vector_type(4)));

constexpr int BATCH = 8, SEQ = 2048, DM = 1024, M = BATCH * SEQ, PROJ = 8192;
constexpr size_t MiB = 1u << 20;
constexpr size_t WS_WCT = MiB / 4, WS_WOT = WS_WCT + 4 * MiB, WS_WGT = WS_WOT + 2 * MiB, WS_GS = WS_WGT + MiB / 2;
constexpr int GS_LD = 4104;
constexpr size_t WS_H3 = 15 * MiB + MiB / 2;
constexpr size_t WS_XN = 16 * MiB, WS_YHT = 16 * MiB, WS_WINT = 48 * MiB, WS_HT = 64 * MiB, WS_YH = 64 * MiB, WS_POOLED = 96 * MiB, WS_MGF = 96 * MiB,
                 WS_ZHT = 160 * MiB, WS_MG = 160 * MiB, WS_PL = 192 * MiB, WS_ZP = 224 * MiB, WS_END = 256 * MiB;
static_assert(WS_GS + (size_t)1024 * GS_LD * 2 <= WS_H3, "ws map");

__device__ __forceinline__ bf16 f2bf(float f) { unsigned u = __float_as_uint(f); return (bf16)((u + 0x7fffu + ((u >> 16) & 1u)) >> 16); }
__device__ __forceinline__ float bf2f(bf16 b) { return __uint_as_float(((unsigned)b) << 16); }
__device__ __forceinline__ float silu_f(float v) { return v / (1.0f + __expf(-v)); }
__device__ __forceinline__ float sigm_f(float v) { return 1.0f / (1.0f + __expf(-v)); }
__device__ __forceinline__ float wave_sum(float v) {
#pragma unroll
    for (int o = 1; o < 64; o <<= 1) v += __shfl_xor(v, o);
    return v;
}

__global__ __launch_bounds__(256) void k_prep_xn(const float* __restrict__ x, const float* __restrict__ g, bf16* __restrict__ XN) {
    const int wave = threadIdx.x >> 6, lane = threadIdx.x & 63, row = blockIdx.x * 4 + wave;
    const f32x4* xr = (const f32x4*)(x + (size_t)row * DM) + lane;
    f32x4 v[4]; float s = 0.f;
#pragma unroll
    for (int j = 0; j < 4; ++j) { v[j] = xr[64 * j]; s += (v[j].x * v[j].x + v[j].y * v[j].y) + (v[j].z * v[j].z + v[j].w * v[j].w); }
    const float rstd = 1.0f / sqrtf(wave_sum(s) * (1.0f / DM) + 1e-6f);
    unsigned long long* o8 = (unsigned long long*)(XN + (size_t)row * DM) + lane;
#pragma unroll
    for (int j = 0; j < 4; ++j) { const f32x4 gg = ((const f32x4*)g)[lane + 64 * j];
        const unsigned lo = (unsigned)f2bf(v[j].x * rstd * gg.x) | ((unsigned)f2bf(v[j].y * rstd * gg.y) << 16), hi = (unsigned)f2bf(v[j].z * rstd * gg.z) | ((unsigned)f2bf(v[j].w * rstd * gg.w) << 16);
        o8[64 * j] = (unsigned long long)lo | ((unsigned long long)hi << 32); }
}
__global__ void k_transpose_w(const float* __restrict__ W, int K, int N, bf16* __restrict__ WT, int ldt, int koff) {
    __shared__ float tile[32][33];
    const int n0 = blockIdx.x * 32, k0 = blockIdx.y * 32, tx = threadIdx.x, ty = threadIdx.y;
#pragma unroll
    for (int i = 0; i < 4; ++i) tile[ty + 8 * i][tx] = W[(size_t)(k0 + ty + 8 * i) * N + n0 + tx];
    __syncthreads();
#pragma unroll
    for (int i = 0; i < 4; ++i) WT[(size_t)(n0 + ty + 8 * i) * ldt + koff + k0 + tx] = f2bf(tile[tx][ty + 8 * i]);
}
__global__ void k_transpose_b(const bf16* __restrict__ S, int R, int C, bf16* __restrict__ D) {
    __shared__ bf16 tile[32][34];
    const int c0 = blockIdx.x * 32, r0 = blockIdx.y * 32, tx = threadIdx.x, ty = threadIdx.y;
#pragma unroll
    for (int i = 0; i < 4; ++i) tile[ty + 8 * i][tx] = S[(size_t)(r0 + ty + 8 * i) * C + c0 + tx];
    __syncthreads();
#pragma unroll
    for (int i = 0; i < 4; ++i) D[(size_t)(c0 + ty + 8 * i) * R + r0 + tx] = tile[tx][ty + 8 * i];
}
__global__ void k_filt_h3(const float* __restrict__ w1, const float* __restrict__ b1, const float* __restrict__ w2, const float* __restrict__ b2,
                          const float* __restrict__ w3, const float* __restrict__ b3, const float* __restrict__ freq, float* __restrict__ H3) {
    __shared__ float z[64], ha[64], hb[64];
    const int l = blockIdx.x, j = threadIdx.x;
    if (j < 33) {
        float zz;
        const float t = (float)l / (float)(SEQ - 1);
        if (j == 0) zz = t;
        else { const int i = (j - 1) & 15; const float w = 6.283185307179586f * (float)l / (float)SEQ; const float f = 1e-4f + (float)i * ((15.0f - 1e-4f) / 15.0f);
               const float ang = w * f; zz = (j <= 16) ? cosf(ang) : -sinf(ang); }
        z[j] = zz;
    }
    __syncthreads();
    const float fr = freq[j];
    float a = b1[j];
    for (int i = 0; i < 33; ++i) a += z[i] * w1[i * 64 + j];
    ha[j] = sinf(fr * a);
    __syncthreads();
    a = b2[j];
    for (int i = 0; i < 64; ++i) a += ha[i] * w2[i * 64 + j];
    hb[j] = sinf(fr * a);
    __syncthreads();
    a = b3[j];
    for (int i = 0; i < 64; ++i) a += hb[i] * w3[i * 64 + j];
    H3[l * 64 + j] = sinf(fr * a);
}
__global__ __launch_bounds__(256) void k_filt_gs(const float* __restrict__ H3, const float* __restrict__ w4, const float* __restrict__ hd, bf16* __restrict__ Gs) {
    __shared__ float wf[64], wb[64];
    const int c = blockIdx.x, tid = threadIdx.x;
    if (tid < 64) wf[tid] = w4[tid * 2048 + c]; else if (tid < 128) wb[tid - 64] = w4[(tid - 64) * 2048 + 1024 + c];
    __syncthreads();
    const float MIN_DECAY = -3.0701134573253945f, MAX_DECAY = -15.350567286626973f;
    const float delta = fabsf(MIN_DECAY + (float)c * ((MAX_DECAY - MIN_DECAY) / 1023.0f));
    bf16* row = Gs + (size_t)c * GS_LD;
    if (tid < 8) row[tid] = 0;
    for (int x = tid; x < 4096; x += 256) {
        float val = 0.f;
        if (x >= 1) {
            const int j = x < 2048 ? 2048 - x : x - 2048;
            const float* h = H3 + j * 64;
            float sf = 0.f, sb = 0.f;
            for (int i = 0; i < 64; ++i) { const float hv = h[i]; sf += hv * wf[i]; sb += hv * wb[i]; }
            const float dec = expf(-((float)j / (float)(SEQ - 1)) * delta);
            if (x < 2048) val = sf * dec; else if (x > 2048) val = sb * dec; else val = sf + sb + hd[c];
        }
        row[8 + x] = f2bf(val);
    }
}

template <class Epi>
__global__ __launch_bounds__(256) void k_gemm_simple(const bf16* __restrict__ A, int lda, size_t aoffz, const bf16* __restrict__ Bt, int ldb, size_t boffz, int K, Epi epi) {
    const int wave = threadIdx.x >> 6, lane = threadIdx.x & 63, r = lane & 31, h = lane >> 5;
    const int m0 = blockIdx.y * 64 + (wave >> 1) * 32, n0 = blockIdx.x * 64 + (wave & 1) * 32, z = blockIdx.z;
    const bf16* ap = A + aoffz * z + (size_t)(m0 + r) * lda + 8 * h;
    const bf16* bp = Bt + boffz * z + (size_t)(n0 + r) * ldb + 8 * h;
    f32x16 acc;
#pragma unroll
    for (int i = 0; i < 16; ++i) acc[i] = 0.f;
    for (int k0 = 0; k0 < K; k0 += 16) {
        const bf16x8 a = *(const bf16x8*)(ap + k0), b = *(const bf16x8*)(bp + k0);
        acc = __builtin_amdgcn_mfma_f32_32x32x16_bf16(a, b, acc, 0, 0, 0);
    }
#pragma unroll
    for (int i = 0; i < 16; ++i) epi(m0 + (i & 3) + 8 * (i >> 2) + 4 * h, n0 + r, z, acc[i]);
}
struct Epi1 { const float* b_in; bf16 *HT, *ZHT, *PL, *ZP, *GT;
    __device__ __forceinline__ void operator()(int m, int n, int, float v) const {
        v += b_in[n];
        if (n < 3072) HT[(size_t)n * M + m] = f2bf(v);
        else if (n < 4096) ZHT[(size_t)(n - 3072) * M + m] = f2bf(silu_f(v));
        else if (n < 5120) PL[(size_t)m * 1024 + (n - 4096)] = f2bf(v);
        else if (n < 6144) ZP[(size_t)m * 1024 + (n - 5120)] = f2bf(silu_f(v));
        else GT[(size_t)m * 2048 + (n - 6144)] = f2bf(sigm_f(v));
    } };
struct EpiPool { const float *pb, *ps; bf16* YP;
    __device__ __forceinline__ void operator()(int m, int n, int g, float v) const {
        const int nn = 256 * g + n; const size_t o = (size_t)m * 1024 + nn;
        YP[o] = f2bf((v + pb[nn]) * ps[nn] * bf2f(YP[o]));
    } };
struct EpiM1 { const bf16* GT; float* MGF;
    __device__ __forceinline__ void operator()(int m, int n, int, float v) const { MGF[(size_t)m * 1024 + n] = v * bf2f(GT[(size_t)m * 2048 + n]); } };
struct EpiM2 { const bf16* GT; const float* MGF; bf16* MG;
    __device__ __forceinline__ void operator()(int m, int n, int, float v) const { const size_t o = (size_t)m * 1024 + n; MG[o] = f2bf(MGF[o] + v * bf2f(GT[(size_t)m * 2048 + 1024 + n])); } };
struct EpiOut { const float* x; float* out;
    __device__ __forceinline__ void operator()(int m, int n, int, float v) const { const size_t o = (size_t)m * 1024 + n; out[o] = x[o] + v; } };

__global__ __launch_bounds__(256) void k_conv_naive(const bf16* __restrict__ HT, const bf16* __restrict__ ZHT, const bf16* __restrict__ Gs,
                                                    const float* __restrict__ cw, const float* __restrict__ cb, bf16* __restrict__ YHT) {
    __shared__ float g[4096];
    __shared__ float u[4][2048];
    const int c = blockIdx.x, bh = blockIdx.y, tid = threadIdx.x;
    for (int x = tid; x < 4096; x += 256) g[x] = bf2f(Gs[(size_t)c * GS_LD + 8 + x]);
    const float w10 = cw[0 * 3072 + 1024 + c], w11 = cw[1 * 3072 + 1024 + c], w12 = cw[2 * 3072 + 1024 + c], b1 = cb[1024 + c];
    const float w20 = cw[0 * 3072 + 2048 + c], w21 = cw[1 * 3072 + 2048 + c], w22 = cw[2 * 3072 + 2048 + c], b2 = cb[2048 + c];
    const float w00 = cw[0 * 3072 + c], w01 = cw[1 * 3072 + c], w02 = cw[2 * 3072 + c], b0 = cb[c];
    const bf16* h0 = HT + (size_t)c * M; const bf16* h1 = HT + (size_t)(1024 + c) * M; const bf16* h2 = HT + (size_t)(2048 + c) * M;
    for (int e = tid; e < 4 * 2048; e += 256) {
        const int b = e >> 11, l = e & 2047; const size_t o = (size_t)(bh * 4 + b) * 2048 + l;
        const float x1 = w10 * (l > 0 ? bf2f(h1[o - 1]) : 0.f) + w11 * bf2f(h1[o]) + w12 * (l < 2047 ? bf2f(h1[o + 1]) : 0.f) + b1;
        const float vv = w20 * (l > 0 ? bf2f(h2[o - 1]) : 0.f) + w21 * bf2f(h2[o]) + w22 * (l < 2047 ? bf2f(h2[o + 1]) : 0.f) + b2;
        u[b][l] = vv * x1;
    }
    __syncthreads();
    float acc[8][4];
#pragma unroll
    for (int ii = 0; ii < 8; ++ii)
#pragma unroll
        for (int b = 0; b < 4; ++b) acc[ii][b] = 0.f;
    for (int k = 0; k < 2048; ++k) {
        float uv[4];
#pragma unroll
        for (int b = 0; b < 4; ++b) uv[b] = u[b][k];
#pragma unroll
        for (int ii = 0; ii < 8; ++ii) { const float gv = g[k - (tid + 256 * ii) + 2048];
#pragma unroll
            for (int b = 0; b < 4; ++b) acc[ii][b] += gv * uv[b]; }
    }
#pragma unroll
    for (int ii = 0; ii < 8; ++ii)
#pragma unroll
        for (int b = 0; b < 4; ++b) {
            const int l = tid + 256 * ii; const size_t o = (size_t)(bh * 4 + b) * 2048 + l;
            const float x0 = w00 * (l > 0 ? bf2f(h0[o - 1]) : 0.f) + w01 * bf2f(h0[o]) + w02 * (l < 2047 ? bf2f(h0[o + 1]) : 0.f) + b0;
            YHT[(size_t)c * M + o] = f2bf(acc[ii][b] * x0 * bf2f(ZHT[(size_t)c * M + o]));
        }
}
__global__ __launch_bounds__(256) void k_pool_naive(const bf16* __restrict__ PL, bf16* __restrict__ P) {
    const size_t idx = (size_t)blockIdx.x * 256 + threadIdx.x; const int c = (int)(idx & 1023), m = (int)(idx >> 10), l = m & 2047, g = c >> 8, w = 2 << g;
    const int lo = max(l - w / 2, 0), hi = min(l + w / 2, SEQ);
    float s = 0.f;
    for (int q = lo; q < hi; ++q) s += bf2f(PL[(size_t)(m - l + q) * 1024 + c]);
    P[idx] = f2bf(s / (float)(hi - lo) - bf2f(PL[idx]));
}
__global__ __launch_bounds__(256) void k_final_norm(float* __restrict__ out, const float* __restrict__ g) {
    const int wave = threadIdx.x >> 6, lane = threadIdx.x & 63, row = blockIdx.x * 4 + wave;
    f32x4* xr = (f32x4*)(out + (size_t)row * DM) + lane;
    f32x4 v[4]; float s = 0.f;
#pragma unroll
    for (int j = 0; j < 4; ++j) { v[j] = xr[64 * j]; s += (v[j].x * v[j].x + v[j].y * v[j].y) + (v[j].z * v[j].z + v[j].w * v[j].w); }
    const float rstd = 1.0f / sqrtf(wave_sum(s) * (1.0f / DM) + 1e-6f);
#pragma unroll
    for (int j = 0; j < 4; ++j) { const f32x4 gg = ((const f32x4*)g)[lane + 64 * j]; xr[64 * j] = v[j] * rstd * gg; }
}

extern "C" void kernel_launch(void* const* d_in, const int* in_sizes, int n_in, void* d_out, int out_size, void* d_ws, size_t ws_size, hipStream_t stream) {
    if (n_in != 22 || out_size != M * DM || ws_size < WS_END) { fprintf(stderr, "kernel_launch: unexpected shapes (n_in %d out %d ws %zu)\n", n_in, out_size, ws_size); return; }
    const float* x = (const float*)d_in[0]; const float* g_norm = (const float*)d_in[1]; const float* w_in = (const float*)d_in[2]; const float* b_in = (const float*)d_in[3];
    const float* conv_w = (const float*)d_in[4]; const float* conv_b = (const float*)d_in[5];
    const float *fw1 = (const float*)d_in[6], *fb1 = (const float*)d_in[7], *fw2 = (const float*)d_in[8], *fb2 = (const float*)d_in[9], *fw3 = (const float*)d_in[10], *fb3 = (const float*)d_in[11],
                *fw4 = (const float*)d_in[12], *ffreq = (const float*)d_in[13], *hyd = (const float*)d_in[14];
    const float *w_ho = (const float*)d_in[15], *pool_w = (const float*)d_in[16], *pool_b = (const float*)d_in[17], *pool_s = (const float*)d_in[18], *w_po = (const float*)d_in[19], *w_out = (const float*)d_in[20], *g_fin = (const float*)d_in[21];
    unsigned char* ws = (unsigned char*)d_ws; float* out = (float*)d_out;
    bf16 *WcT = (bf16*)(ws + WS_WCT), *WoT = (bf16*)(ws + WS_WOT), *WgT = (bf16*)(ws + WS_WGT), *Gs = (bf16*)(ws + WS_GS), *XN = (bf16*)(ws + WS_XN), *YHT = (bf16*)(ws + WS_YHT),
         *WinT = (bf16*)(ws + WS_WINT), *HT = (bf16*)(ws + WS_HT), *YH = (bf16*)(ws + WS_YH), *POOLED = (bf16*)(ws + WS_POOLED), *ZHT = (bf16*)(ws + WS_ZHT), *MG = (bf16*)(ws + WS_MG),
         *PL = (bf16*)(ws + WS_PL), *ZP = (bf16*)(ws + WS_ZP), *GT = (bf16*)d_out;
    float *H3 = (float*)(ws + WS_H3), *MGF = (float*)(ws + WS_MGF);
    k_prep_xn<<<M / 4, 256, 0, stream>>>(x, g_norm, XN);
    k_transpose_w<<<dim3(PROJ / 32, DM / 32), dim3(32, 8), 0, stream>>>(w_in, DM, PROJ, WinT, DM, 0);
    k_transpose_w<<<dim3(DM / 32, DM / 32), dim3(32, 8), 0, stream>>>(w_ho, DM, DM, WcT, 2048, 0);
    k_transpose_w<<<dim3(DM / 32, DM / 32), dim3(32, 8), 0, stream>>>(w_po, DM, DM, WcT, 2048, 1024);
    k_transpose_w<<<dim3(DM / 32, DM / 32), dim3(32, 8), 0, stream>>>(w_out, DM, DM, WoT, DM, 0);
    for (int g = 0; g < 4; ++g) k_transpose_w<<<dim3(8, 8), dim3(32, 8), 0, stream>>>(pool_w + (size_t)g * 65536, 256, 256, WgT + (size_t)g * 65536, 256, 0);
    k_filt_h3<<<SEQ, 64, 0, stream>>>(fw1, fb1, fw2, fb2, fw3, fb3, ffreq, H3);
    k_filt_gs<<<1024, 256, 0, stream>>>(H3, fw4, hyd, Gs);
    k_gemm_simple<Epi1><<<dim3(PROJ / 64, M / 64, 1), 256, 0, stream>>>(XN, DM, 0, WinT, DM, 0, DM, Epi1{b_in, HT, ZHT, PL, ZP, GT});
    k_conv_naive<<<dim3(1024, 2), 256, 0, stream>>>(HT, ZHT, Gs, conv_w, conv_b, YHT);
    k_transpose_b<<<dim3(M / 32, 1024 / 32), dim3(32, 8), 0, stream>>>(YHT, 1024, M, YH);
    k_pool_naive<<<(unsigned)((size_t)M * 1024 / 256), 256, 0, stream>>>(PL, POOLED);
    k_gemm_simple<EpiPool><<<dim3(256 / 64, M / 64, 4), 256, 0, stream>>>(POOLED, 1024, 256, WgT, 256, 65536, 256, EpiPool{pool_b, pool_s, ZP});
    k_gemm_simple<EpiM1><<<dim3(DM / 64, M / 64, 1), 256, 0, stream>>>(YH, 1024, 0, WcT, 2048, 0, 1024, EpiM1{GT, MGF});
    k_gemm_simple<EpiM2><<<dim3(DM / 64, M / 64, 1), 256, 0, stream>>>(ZP, 1024, 0, WcT + 1024, 2048, 0, 1024, EpiM2{GT, MGF, MG});
    k_gemm_simple<EpiOut><<<dim3(DM / 64, M / 64, 1), 256, 0, stream>>>(MG, 1024, 0, WoT, 1024, 0, 1024, EpiOut{x, out});
    k_final_norm<<<M / 4, 256, 0, stream>>>(out, g_fin);
}
```

```cpp
#include <hip/hip_runtime.h>
#include <cstdio>
#include <cstdint>
namespace pg8 {
#define PG8_LAS __attribute__((address_space(3)))
typedef unsigned short bf16_t;
typedef short bf16x8 __attribute__((ext_vector_type(8)));
typedef float f32x4 __attribute__((ext_vector_type(4)));
typedef unsigned u32x4 __attribute__((ext_vector_type(4)));
typedef unsigned u32x2 __attribute__((ext_vector_type(2)));
constexpr int BM = 256, BK = 64, HALF = 128, HTB = HALF * BK * 2  , STAGE_BYTES = 8 * HTB, NXCD = 8, WGM = 8;

__host__ __device__ __forceinline__ int lds_byte(int r, int c) { const int st = (r >> 4) * 2 + (c >> 5), rr = r & 15, cc = c & 31, ob = rr * 64 + cc * 2; return st * 1024 + (ob ^ (((ob >> 9) & 1) << 5)); }
__host__ __device__ __forceinline__ void stage_rc(int b, int& R, int& C) { const int st = b / 1024, sb = b % 1024, swz = sb ^ (((sb >> 9) & 1) << 5); R = (st >> 1) * 16 + swz / 64; C = (st & 1) * 32 + (swz % 64) / 2; }
__host__ __device__ __forceinline__ int perm32(int rho) { const int n = rho >> 4, i = rho & 15; return 8 * (i >> 2) + 4 * n + (i & 3); }

struct Unit { int pm, pn; };
struct Gemm { const bf16_t* A; const bf16_t* A2; const bf16_t* Bt; int lda, ldb, M, N, K, nth; };

struct StaticOrder {
    int nM, nN, nwg, G, c;
    __host__ __device__ void init(int M, int N, int G_, int c_) { nM = M / BM; nN = N / BM; nwg = nM * nN; G = G_; c = c_; }
    __host__ __device__ bool next(int i, Unit& u) const {
        const long L = (long)i * G + c; if (L >= nwg) return false;
        int wgid = (int)L; { const int q = nwg / NXCD, r = nwg % NXCD, xcd = wgid % NXCD, off = wgid / NXCD; wgid = (xcd < r ? xcd * (q + 1) : r * (q + 1) + (xcd - r) * q) + off; }
        const int nig = WGM * nN, gid = wgid / nig, fm = gid * WGM, gsz = (nM - fm) < WGM ? (nM - fm) : WGM;
        u.pm = fm + ((wgid % nig) % gsz); u.pn = (wgid % nig) / gsz; return true;
    }
};
__device__ __forceinline__ unsigned cvt_pk_bf16(float lo, float hi) { unsigned r; asm volatile("v_cvt_pk_bf16_f32 %0, %1, %2" : "=v"(r) : "v"(lo), "v"(hi)); return r; }

template <class Epi, bool ALIGN_EPI, bool SP2, bool DUAL>
__device__ __forceinline__ void gemm_phase(PG8_LAS unsigned char* lds, const Gemm g, const StaticOrder& S, const Epi& E) {
    const int tid = threadIdx.x, wid = __builtin_amdgcn_readfirstlane(tid >> 6), lane = tid & 63, wr = wid >> 2, wc = wid & 3, fr = lane & 15, fq = lane >> 4;
    const int K = g.K, nt = K / BK, nth = g.nth;
    unsigned voffA[2], voffB[2];
#pragma unroll
    for (int i = 0; i < 2; ++i) { int R, C; stage_rc(tid * 16 + i * 8192, R, C); const int Rb = Epi::PERM ? ((R & ~31) + perm32(R & 31)) : R; const int Ra = Epi::TRANS ? ((R & ~31) + perm32(R & 31)) : R;
        voffA[i] = (unsigned)(Ra * g.lda + C) * 2u; voffB[i] = (unsigned)(Rb * g.ldb + C) * 2u; }
    const size_t kstep = (size_t)(BK * 2);
    const size_t hstepA = (size_t)HALF * g.lda * 2, hstepB = (size_t)HALF * g.ldb * 2;
    const size_t tstepA = 2 * hstepA, tstepB = 2 * hstepB;
    const long a2delta = DUAL ? ((const char*)g.A2 - (const char*)g.A) - (long)nth * (long)kstep : 0;
    const unsigned ldsw = (unsigned)wid * 1024u;
    const int aoff = lds_byte(wr * 64 + fr, fq * 8), boff = lds_byte(wc * 32 + fr, fq * 8);
#define PG8_SA(b, h) (((b) * 2 + (h)) * HTB)
#define PG8_SB(b, h) ((4 + (b) * 2 + (h)) * HTB)
#define PG8_STAGE(bufoff, gbase, voff) do { _Pragma("unroll") for (int _i = 0; _i < 2; ++_i) \
        __builtin_amdgcn_global_load_lds((const unsigned*)((const char*)(gbase) + (voff)[_i]), (PG8_LAS unsigned*)(lds + (bufoff) + ldsw + _i * 8192), 16, 0, 0); } while (0)
#define PG8_LDA(dst, b, h) do { _Pragma("unroll") for (int m = 0; m < 4; ++m) _Pragma("unroll") for (int k = 0; k < 2; ++k) dst[m][k] = *(const PG8_LAS bf16x8*)(lds + PG8_SA(b, h) + aoff + m * 2048 + k * 1024); } while (0)
#define PG8_LDB(dst, b, h) do { _Pragma("unroll") for (int n = 0; n < 2; ++n) _Pragma("unroll") for (int k = 0; k < 2; ++k) dst[n][k] = *(const PG8_LAS bf16x8*)(lds + PG8_SB(b, h) + boff + n * 2048 + k * 1024); } while (0)
#define PG8_MMA(ai, bj, At, Bt) do { __builtin_amdgcn_s_setprio(1); _Pragma("unroll") for (int m = 0; m < 4; ++m) _Pragma("unroll") for (int n = 0; n < 2; ++n) _Pragma("unroll") for (int k = 0; k < 2; ++k) \
        acc[ai][bj][m][n] = Epi::TRANS ? __builtin_amdgcn_mfma_f32_16x16x32_bf16(At[m][k], Bt[n][k], acc[ai][bj][m][n], 0, 0, 0) : __builtin_amdgcn_mfma_f32_16x16x32_bf16(Bt[n][k], At[m][k], acc[ai][bj][m][n], 0, 0, 0); __builtin_amdgcn_s_setprio(0); } while (0)
#define PG8_WAIT_V(n) asm volatile("s_waitcnt vmcnt(" #n ")" ::: "memory")
#define PG8_WAIT_L(n) asm volatile("s_waitcnt lgkmcnt(" #n ")" ::: "memory")
#define PG8_BAR __builtin_amdgcn_s_barrier()
#define PG8_SCHED __builtin_amdgcn_sched_barrier(0)
#define PG8_AT(base, tt) ((DUAL && (tt) >= nth) ? (base) + a2delta + (size_t)(tt) * kstep : (base) + (size_t)(tt) * kstep)
    Unit cur, nxt; int ui = 0;
    if (!S.next(0, cur)) return;
    f32x4 acc[2][2][4][2];
#pragma unroll
    for (int a = 0; a < 2; ++a)
#pragma unroll
        for (int b = 0; b < 2; ++b)
#pragma unroll
            for (int m = 0; m < 4; ++m)
#pragma unroll
                for (int n = 0; n < 2; ++n) acc[a][b][m][n] = (f32x4){0.f, 0.f, 0.f, 0.f};
    bf16x8 At[4][2], B0[2][2], B1[2][2];
    const char* cA = (const char*)g.A + (size_t)cur.pm * tstepA; const char* cB = (const char*)g.Bt + (size_t)cur.pn * tstepB;
    if constexpr (SP2) {
        PG8_STAGE(PG8_SB(0, 0), cB, voffB); PG8_STAGE(PG8_SB(0, 1), cB + hstepB, voffB); PG8_STAGE(PG8_SA(0, 0), cA, voffA); PG8_STAGE(PG8_SA(0, 1), cA + hstepA, voffA);
        if (wr == 1) PG8_BAR;
        PG8_WAIT_V(2); PG8_BAR;
        PG8_STAGE(PG8_SB(1, 0), cB + kstep, voffB); PG8_STAGE(PG8_SA(1, 0), cA + kstep, voffA); PG8_STAGE(PG8_SB(1, 1), cB + hstepB + kstep, voffB);
        PG8_WAIT_V(6); PG8_BAR;
    } else {
        PG8_STAGE(PG8_SB(0, 0), cB, voffB); PG8_STAGE(PG8_SA(0, 0), cA, voffA); PG8_STAGE(PG8_SB(0, 1), cB + hstepB, voffB); PG8_STAGE(PG8_SA(0, 1), cA + hstepA, voffA);
        if (wr == 1) PG8_BAR;
        PG8_WAIT_V(4); PG8_BAR;
        PG8_STAGE(PG8_SB(1, 0), cB + kstep, voffB); PG8_STAGE(PG8_SA(1, 0), cA + kstep, voffA); PG8_STAGE(PG8_SB(1, 1), cB + hstepB + kstep, voffB);
        PG8_WAIT_V(6); PG8_BAR;
    }
    for (;;) {
        const bool has_next = S.next(ui + 1, nxt);
        const char* nA = has_next ? (const char*)g.A + (size_t)nxt.pm * tstepA : cA; const char* nB = has_next ? (const char*)g.Bt + (size_t)nxt.pn * tstepB : cB;
        for (int t = 0; t < nt; t += 2) {
            const bool last = (t == nt - 2);
            if constexpr (Epi::HAS_MID) { if (t == nth) E.mid(acc, cur, wr, wc, fr, fq); }
            const char* a1 = PG8_AT(cA, t + 1);
            const char* a2 = last ? nA : PG8_AT(cA, t + 2); const char* b2 = last ? nB : cB + (size_t)(t + 2) * kstep;
            const char* a3 = last ? nA + kstep : PG8_AT(cA, t + 3); const char* b3 = b2 + kstep;
            if constexpr (SP2) {
            PG8_LDB(B0, 0, 0); PG8_LDB(B1, 0, 1); PG8_SCHED; PG8_LDA(At, 0, 0); PG8_STAGE(PG8_SA(1, 1), a1 + hstepA, voffA);
            PG8_WAIT_V(8); PG8_WAIT_L(0); PG8_BAR; PG8_MMA(0, 0, At, B0); PG8_MMA(0, 1, At, B1); PG8_BAR; PG8_SCHED;
            PG8_LDA(At, 0, 1); PG8_STAGE(PG8_SB(0, 0), b2, voffB); PG8_STAGE(PG8_SB(0, 1), b2 + hstepB, voffB); PG8_STAGE(PG8_SA(0, 0), a2, voffA);
            PG8_WAIT_V(8); PG8_WAIT_L(0); PG8_BAR; PG8_MMA(1, 0, At, B0); PG8_MMA(1, 1, At, B1); PG8_BAR; PG8_SCHED;
            PG8_LDB(B0, 1, 0); PG8_LDB(B1, 1, 1); PG8_SCHED; PG8_LDA(At, 1, 0); PG8_STAGE(PG8_SA(0, 1), a2 + hstepA, voffA);
            PG8_WAIT_V(8); PG8_WAIT_L(0); PG8_BAR; PG8_MMA(0, 0, At, B0); PG8_MMA(0, 1, At, B1); PG8_BAR; PG8_SCHED;
            PG8_LDA(At, 1, 1); PG8_STAGE(PG8_SB(1, 0), b3, voffB); PG8_STAGE(PG8_SB(1, 1), b3 + hstepB, voffB); PG8_STAGE(PG8_SA(1, 0), a3, voffA);
            PG8_WAIT_V(8); PG8_WAIT_L(0); PG8_BAR; PG8_MMA(1, 0, At, B0); PG8_MMA(1, 1, At, B1); PG8_BAR; PG8_SCHED;
            } else {
            PG8_LDB(B0, 0, 0); PG8_SCHED; PG8_LDA(At, 0, 0); PG8_STAGE(PG8_SA(1, 1), a1 + hstepA, voffA);
            PG8_WAIT_L(8); PG8_BAR; PG8_WAIT_L(0); PG8_MMA(0, 0, At, B0); PG8_BAR; PG8_SCHED;
            PG8_LDB(B1, 0, 1); PG8_STAGE(PG8_SB(0, 0), b2, voffB);
            PG8_BAR; PG8_WAIT_L(0); PG8_MMA(0, 1, At, B1); PG8_BAR;
            PG8_LDA(At, 0, 1); PG8_STAGE(PG8_SA(0, 0), a2, voffA);
            PG8_BAR; PG8_WAIT_L(0); PG8_MMA(1, 0, At, B0); PG8_BAR; PG8_SCHED;
            PG8_STAGE(PG8_SB(0, 1), b2 + hstepB, voffB);
            PG8_WAIT_V(6); PG8_BAR; PG8_MMA(1, 1, At, B1); PG8_BAR;
            PG8_LDB(B0, 1, 0); PG8_SCHED; PG8_LDA(At, 1, 0); PG8_STAGE(PG8_SA(0, 1), a2 + hstepA, voffA);
            PG8_WAIT_L(8); PG8_BAR; PG8_WAIT_L(0); PG8_MMA(0, 0, At, B0); PG8_BAR; PG8_SCHED;
            PG8_LDB(B1, 1, 1); PG8_STAGE(PG8_SB(1, 0), b3, voffB);
            PG8_BAR; PG8_WAIT_L(0); PG8_MMA(0, 1, At, B1); PG8_BAR;
            PG8_LDA(At, 1, 1); PG8_STAGE(PG8_SA(1, 0), a3, voffA);
            PG8_BAR; PG8_WAIT_L(0); PG8_MMA(1, 0, At, B0); PG8_BAR; PG8_SCHED;
            PG8_STAGE(PG8_SB(1, 1), b3 + hstepB, voffB);
            PG8_WAIT_V(6); PG8_BAR; PG8_MMA(1, 1, At, B1); PG8_BAR;
            }
        }
        if constexpr (ALIGN_EPI) { if (wr == 0) PG8_BAR; }
        E(acc, cur, wr, wc, fr, fq);
        if (!has_next) break;
#pragma unroll
        for (int a = 0; a < 2; ++a)
#pragma unroll
            for (int b = 0; b < 2; ++b)
#pragma unroll
                for (int m = 0; m < 4; ++m)
#pragma unroll
                    for (int n = 0; n < 2; ++n) acc[a][b][m][n] = (f32x4){0.f, 0.f, 0.f, 0.f};
        cur = nxt; cA = nA; cB = nB; ++ui;
        if constexpr (ALIGN_EPI) { if (wr == 1) PG8_BAR; }
    }
    PG8_WAIT_V(0);
    if constexpr (!ALIGN_EPI) { if (wr == 0) PG8_BAR; }
    PG8_BAR;
#undef PG8_SA
#undef PG8_SB
#undef PG8_STAGE
#undef PG8_LDA
#undef PG8_LDB
#undef PG8_MMA
#undef PG8_WAIT_V
#undef PG8_WAIT_L
#undef PG8_BAR
#undef PG8_SCHED
#undef PG8_AT
}
}
typedef unsigned short bf16;
typedef short bf16x8 __attribute__((ext_vector_type(8)));
typedef float f32x16 __attribute__((ext_vector_type(16)));
typedef float f32x4 __attribute__((ext_vector_type(4)));
typedef unsigned v4u __attribute__((ext_vector_type(4)));
typedef unsigned v2u __attribute__((ext_vector_type(2)));
#define GAS __attribute__((address_space(1)))
#define LAS __attribute__((address_space(3)))
typedef GAS unsigned gu32;
#define RLX_AGENT __ATOMIC_RELAXED, __HIP_MEMORY_SCOPE_AGENT
#define LDS_WAIT() asm volatile("s_waitcnt lgkmcnt(0)" ::: "memory")
#define VM_WAIT() asm volatile("s_waitcnt vmcnt(0)" ::: "memory")

constexpr int NWAVES = 8;
constexpr int BATCH = 8, SEQ = 2048, DM = 1024, M = BATCH * SEQ, PROJ = 8192;
constexpr size_t MiB = 1u << 20;
constexpr size_t WS_CTL = 0, CTL_ZERO_BYTES = 64 * 1024;
constexpr size_t WS_WCT = MiB / 4, WS_WOT = WS_WCT + 4 * MiB, WS_WGT = WS_WOT + 2 * MiB, WS_GS = WS_WGT + MiB / 2;
constexpr int GS_LD = 4104;
constexpr size_t WS_H3 = 15 * MiB + MiB / 2;
constexpr size_t WS_XN = 16 * MiB, WS_YHT = 16 * MiB, WS_WINT = 48 * MiB, WS_HT = 64 * MiB, WS_YH = 64 * MiB, WS_POOLED = 96 * MiB, WS_MGF = 96 * MiB,
                 WS_ZHT = 160 * MiB, WS_MG = 160 * MiB, WS_PL = 192 * MiB, WS_ZP = 224 * MiB, WS_END = 256 * MiB;
static_assert(WS_GS + (size_t)1024 * GS_LD * 2 <= WS_H3 && WS_ZP == WS_PL + (size_t)M * 1024 * 2, "ws map");
constexpr int CW_BAR = 1024;
constexpr int RING_OFF = 0, RING_BYTES = 131072;
constexpr int LDSCTL_OFF = 139264, MISC_OFF = LDSCTL_OFF + 320;
constexpr int LDS_BYTES = 147456;

__device__ __forceinline__ unsigned f2bf(float f) { unsigned u = __builtin_bit_cast(unsigned, f); return (u + 0x7fffu + ((u >> 16) & 1u)) >> 16; }
__device__ __forceinline__ unsigned pk2(float lo, float hi) { return f2bf(lo) | (f2bf(hi) << 16); }
__device__ __forceinline__ float bf2f(unsigned b) { return __builtin_bit_cast(float, b << 16); }
__device__ __forceinline__ float bflo(unsigned w) { return __builtin_bit_cast(float, w << 16); }
__device__ __forceinline__ float bfhi(unsigned w) { return __builtin_bit_cast(float, w & 0xffff0000u); }
__device__ __forceinline__ float silu_f(float v) { return v / (1.0f + __expf(-v)); }
__device__ __forceinline__ float sigm_f(float v) { return 1.0f / (1.0f + __expf(-v)); }
__device__ __forceinline__ float wave_sum(float v) {
#pragma unroll
    for (int o = 1; o < 64; o <<= 1) v += __shfl_xor(v, o);
    return v;
}

#define XB_TMO      128
#define XB_XCNT(j)  (256  + 64 * (j))
#define XB_XSUB(j)  (1280 + 64 * (j))
#define XB_XGEN(j)  (2304 + 64 * (j))
#define XB_TOP      3328
#define XB_TOPGEN   3392
#define XCD_BAR_WORDS 3456
#define XB_SPIN_CAP (1u << 18)
__device__ __forceinline__ unsigned xb_ld(unsigned* p)              { return __hip_atomic_load(p, __ATOMIC_RELAXED, __HIP_MEMORY_SCOPE_AGENT); }
__device__ __forceinline__ unsigned xb_add(unsigned* p, unsigned v) { return __hip_atomic_fetch_add(p, v, __ATOMIC_RELAXED, __HIP_MEMORY_SCOPE_AGENT); }
__device__ __forceinline__ unsigned xb_xcc_id() { return (unsigned)__builtin_amdgcn_s_getreg((3 << 11) | 20) & 0xFu; }
#define XB_SPIN(cond, bar) do { unsigned _sp = 0; while (cond) { __builtin_amdgcn_s_sleep(1); \
    if ((++_sp & 255u) == 0u) { if (xb_ld(&(bar)[XB_TMO])) break; if (_sp > XB_SPIN_CAP) { atomicAdd(&(bar)[XB_TMO], 1u); break; } } } } while (0)
struct XcdBarrier { unsigned* bar; unsigned x; volatile LAS unsigned* st; };
__device__ __forceinline__ XcdBarrier xcd_barrier_post(unsigned* bar, volatile LAS unsigned* st) {
    XcdBarrier b; b.bar = bar; b.x = xb_xcc_id(); b.st = st;
    if (threadIdx.x == 0) (void)xb_add(&bar[XB_XCNT(b.x)], 1u);
    return b;
}
__device__ __forceinline__ void xcd_barrier_complete(unsigned* bar, unsigned x, unsigned& nloc, unsigned& nx) {
    const unsigned G = gridDim.x * gridDim.y * gridDim.z;
    unsigned sum, cnt, mine, sp = 0u;
    for (;;) {
        sum = 0u; cnt = 0u; mine = 0u;
#pragma unroll
        for (unsigned j = 0; j < 16; ++j) { const unsigned c = xb_ld(&bar[XB_XCNT(j)]); sum += c; cnt += (c > 0u) ? 1u : 0u; mine = (j == x) ? c : mine; }
        if (sum == G) break;
        __builtin_amdgcn_s_sleep(1);
        if ((++sp & 255u) == 0u) { if (xb_ld(&bar[XB_TMO])) break; if (sp > XB_SPIN_CAP) { atomicAdd(&bar[XB_TMO], 1u); break; } }
    }
    nloc = mine > 0u ? mine : 1u; nx = cnt > 0u ? cnt : 1u;
}
__device__ __forceinline__ void xcd_barrier(const XcdBarrier& b) {
    asm volatile("s_waitcnt vmcnt(0)" ::: "memory");
    __syncthreads();
    if (threadIdx.x == 0) {
        unsigned* bar = b.bar;
        __builtin_amdgcn_s_waitcnt(0);
        unsigned nloc = b.st[0], nx = b.st[1];
        if (nloc == 0u) { xcd_barrier_complete(bar, b.x, nloc, nx); b.st[0] = nloc; b.st[1] = nx; }
        const unsigned old = xb_add(&bar[XB_XSUB(b.x)], 1u);
        const unsigned gen = old / nloc;
        if (old + 1u == (gen + 1u) * nloc) {
            __builtin_amdgcn_fence(__ATOMIC_RELEASE, "agent");
            asm volatile("s_waitcnt vmcnt(0)" ::: "memory");
            const unsigned og = xb_add(&bar[XB_TOP], 1u);
            const unsigned tg = og / nx;
            if (og + 1u == (tg + 1u) * nx) xb_add(&bar[XB_TOPGEN], 1u);
            else XB_SPIN(xb_ld(&bar[XB_TOPGEN]) == tg, bar);
            __builtin_amdgcn_fence(__ATOMIC_ACQUIRE, "agent");
            xb_add(&bar[XB_XGEN(b.x)], 1u);
            asm volatile("s_waitcnt vmcnt(0)" ::: "memory");
        } else {
            XB_SPIN(xb_ld(&bar[XB_XGEN(b.x)]) == gen, bar);
            __builtin_amdgcn_fence(__ATOMIC_ACQUIRE, "agent");
            asm volatile("s_waitcnt vmcnt(0)" ::: "memory");
        }
    }
    __syncthreads();
}
struct Args {
    const float *x, *g_norm, *w_in, *b_in, *conv_w, *conv_b, *fw1, *fb1, *fw2, *fb2, *fw3, *fb3, *fw4, *ffreq, *hyd, *w_ho, *pool_w, *pool_b, *pool_s, *w_po, *w_out, *g_fin;
    float* out; unsigned char* ws; int ph_lo, ph_hi, li, pad;
};
#define CAS __attribute__((address_space(4)))
template <class T> __device__ __forceinline__ const CAS T* as_const(const T* p) { return (const CAS T*)(unsigned long long)p; }

__device__ __forceinline__ void p0_transpose_item(const float* W, int K, int N, bf16* WT, int ldt, int koff, LAS float* scr, int item, int lane) {
    const int nblk = N / 32, kb = item / nblk, nb = item % nblk, k0 = 64 * kb, n0 = 32 * nb;
#pragma unroll 8
    for (int i = 0; i < 32; ++i) { const int kk = 2 * i + (lane >> 5); scr[kk * 33 + (lane & 31)] = W[(size_t)(k0 + kk) * N + n0 + (lane & 31)]; }
    LDS_WAIT(); asm volatile("" ::: "memory");
    const int c = lane & 7;
#pragma unroll
    for (int j = 0; j < 4; ++j) { const int n = (lane >> 3) + 8 * j; const LAS float* s = scr + (8 * c) * 33 + n;
        v4u o; o.x = pk2(s[0 * 33], s[1 * 33]); o.y = pk2(s[2 * 33], s[3 * 33]); o.z = pk2(s[4 * 33], s[5 * 33]); o.w = pk2(s[6 * 33], s[7 * 33]);
        *(GAS v4u*)(WT + (size_t)(n0 + n) * ldt + koff + k0 + 8 * c) = o; }
    LDS_WAIT(); asm volatile("" ::: "memory");
}
__device__ __forceinline__ void p0_xn_row(const float* xrow, const float* g, bf16* orow, int lane) {
    const GAS f32x4* xr = (const GAS f32x4*)xrow + lane;
    f32x4 v[4]; float s = 0.f;
#pragma unroll
    for (int j = 0; j < 4; ++j) { v[j] = xr[64 * j]; s += (v[j].x * v[j].x + v[j].y * v[j].y) + (v[j].z * v[j].z + v[j].w * v[j].w); }
    const float rstd = 1.0f / sqrtf(wave_sum(s) * (1.0f / DM) + 1e-6f);
    GAS unsigned long long* o8 = (GAS unsigned long long*)orow + lane;
#pragma unroll
    for (int j = 0; j < 4; ++j) { const f32x4 gg = ((const GAS f32x4*)g)[lane + 64 * j];
        o8[64 * j] = (unsigned long long)pk2(v[j].x * rstd * gg.x, v[j].y * rstd * gg.y) | ((unsigned long long)pk2(v[j].z * rstd * gg.z, v[j].w * rstd * gg.w) << 32); }
}
__device__ __forceinline__ void p0_h3_row(const Args& a, LAS float* scr, float* H3, int l, int lane) {
    float zz = 0.f;
    if (lane < 33) {
        if (lane == 0) zz = (float)l / (float)(SEQ - 1);
        else { const int i = (lane - 1) & 15; const float w = 6.283185307179586f * (float)l / (float)SEQ; const float f = 1e-4f + (float)i * ((15.0f - 1e-4f) / 15.0f);
               const float ang = w * f; zz = (lane <= 16) ? cosf(ang) : -sinf(ang); }
    }
    scr[lane] = zz;
    LDS_WAIT(); asm volatile("" ::: "memory");
    const float fr = a.ffreq[lane];
    float acc = a.fb1[lane];
    for (int i = 0; i < 33; ++i) acc += scr[i] * a.fw1[i * 64 + lane];
    scr[64 + lane] = sinf(fr * acc);
    LDS_WAIT(); asm volatile("" ::: "memory");
    acc = a.fb2[lane];
    for (int i = 0; i < 64; ++i) acc += scr[64 + i] * a.fw2[i * 64 + lane];
    scr[128 + lane] = sinf(fr * acc);
    LDS_WAIT(); asm volatile("" ::: "memory");
    acc = a.fb3[lane];
    for (int i = 0; i < 64; ++i) acc += scr[128 + i] * a.fw3[i * 64 + lane];
    H3[l * 64 + lane] = sinf(fr * acc);
    LDS_WAIT(); asm volatile("" ::: "memory");
}
__device__ __forceinline__ void p0_prologue(const Args& a, LAS unsigned char* lds, int gw, int NGW, int wave, int lane) {
    unsigned char* ws = a.ws;
    LAS float* scr = (LAS float*)(lds + RING_OFF + wave * 16384);
    float* H3 = (float*)(ws + WS_H3);
    for (int l = gw; l < SEQ; l += NGW) { int ln = lane; asm volatile("" : "+v"(ln)); p0_h3_row(a, scr, H3, l, ln); }
    constexpr int I_IN = (DM / 64) * (PROJ / 32), I_SQ = (DM / 64) * (DM / 32), I_PG = (256 / 64) * (256 / 32);
    constexpr int NITEMS = I_IN + 3 * I_SQ + 4 * I_PG;
    bf16 *WinT = (bf16*)(ws + WS_WINT), *WcT = (bf16*)(ws + WS_WCT), *WoT = (bf16*)(ws + WS_WOT), *WgT = (bf16*)(ws + WS_WGT);
    for (int it = gw; it < NITEMS; it += NGW) {
        int r = it;
        if (r < I_IN) { p0_transpose_item(a.w_in, DM, PROJ, WinT, DM, 0, scr, r, lane); continue; } r -= I_IN;
        if (r < I_SQ) { p0_transpose_item(a.w_ho, DM, DM, WcT, 2048, 0, scr, r, lane); continue; } r -= I_SQ;
        if (r < I_SQ) { p0_transpose_item(a.w_po, DM, DM, WcT, 2048, 1024, scr, r, lane); continue; } r -= I_SQ;
        if (r < I_SQ) { p0_transpose_item(a.w_out, DM, DM, WoT, DM, 0, scr, r, lane); continue; } r -= I_SQ;
        const int g = r / I_PG; p0_transpose_item(a.pool_w + (size_t)g * 65536, 256, 256, WgT + (size_t)g * 65536, 256, 0, scr, r % I_PG, lane);
    }
    bf16* XN = (bf16*)(ws + WS_XN);
    for (int m = gw; m < M; m += NGW) { int ln = lane; asm volatile("" : "+v"(ln)); p0_xn_row(a.x + (size_t)m * DM, a.g_norm, XN + (size_t)m * DM, ln); }
}
__device__ __forceinline__ void gs_item(const Args& a, const float* H3, bf16* Gs, int item, int lane) {
    const int pb = item & 31, cg = item >> 5, c0 = 16 * cg, j = 64 * pb + lane;
    float af[16], ab[16];
#pragma unroll
    for (int cc = 0; cc < 16; ++cc) { af[cc] = 0.f; ab[cc] = 0.f; }
    const CAS float* w4 = as_const(a.fw4) + c0;
    const GAS f32x4* hp = (const GAS f32x4*)(H3 + (size_t)j * 64);
#pragma unroll 1
    for (int i4 = 0; i4 < 16; ++i4) {
        const f32x4 hq = hp[i4];
        const CAS float* wr_ = w4 + i4 * 4 * 2048;
#pragma unroll
        for (int e = 0; e < 4; ++e) {
            const float hv = hq[e];
#pragma unroll
            for (int cc = 0; cc < 16; ++cc) { af[cc] += hv * wr_[e * 2048 + cc]; ab[cc] += hv * wr_[e * 2048 + 1024 + cc]; }
        }
    }
    const float MIN_DECAY = -3.0701134573253945f, MAX_DECAY = -15.350567286626973f;
    const float t = (float)j / (float)(SEQ - 1);
#pragma unroll
    for (int cc = 0; cc < 16; ++cc) {
        const int c = c0 + cc;
        const float delta = fabsf(MIN_DECAY + (float)c * ((MAX_DECAY - MIN_DECAY) / 1023.0f));
        const float dec = expf(-t * delta);
        bf16* row = Gs + (size_t)c * GS_LD + 8;
        if (j == 0) { row[2048] = (bf16)f2bf(af[cc] + ab[cc] + a.hyd[c]); }
        else { row[2048 - j] = (bf16)f2bf(af[cc] * dec); row[2048 + j] = (bf16)f2bf(ab[cc] * dec); }
        if (pb == 0 && lane < 9) row[(int)lane - 8] = 0;
    }
}

struct EpiP1N {
    static constexpr bool PERM = true, TRANS = false, HAS_MID = false;
    const float* bias; bf16 *PL, *GT; int pn_off;
    __device__ __forceinline__ void operator()(const pg8::f32x4 (&acc)[2][2][4][2], const pg8::Unit& u, int wr, int wc, int fr, int fq) const {
        const int pn = u.pn + pn_off;
        const bool isg = pn >= 24; const int act = pn < 20 ? 0 : (pn < 24 ? 1 : 2), ldc = isg ? 2048 : 1024, colt = (isg ? pn - 24 : (pn & 3)) * 256;
        bf16* base = isg ? GT : PL + (pn >= 20 ? (size_t)M * 1024 : (size_t)0);
        const int row0 = u.pm * 256 + wr * 64 + fr, col0 = colt + wc * 32 + 8 * fq, bcol0 = pn * 256 + wc * 32 + 8 * fq;
        pg8::f32x4 bv[2][2];
#pragma unroll
        for (int bj = 0; bj < 2; ++bj)
#pragma unroll
            for (int n = 0; n < 2; ++n) bv[bj][n] = *(const pg8::f32x4*)(bias + bcol0 + bj * 128 + 4 * n);
#pragma unroll
        for (int ai = 0; ai < 2; ++ai)
#pragma unroll
            for (int m = 0; m < 4; ++m) { bf16* rowp = base + (size_t)(row0 + ai * 128 + m * 16) * ldc + col0;
#pragma unroll
                for (int bj = 0; bj < 2; ++bj) { pg8::f32x4 v0 = acc[ai][bj][m][0] + bv[bj][0], v1 = acc[ai][bj][m][1] + bv[bj][1];
                    if (act != 0) {
#pragma unroll
                        for (int e = 0; e < 4; ++e) { const float s0 = __builtin_amdgcn_rcpf(1.0f + __expf(-v0[e])), s1 = __builtin_amdgcn_rcpf(1.0f + __expf(-v1[e]));
                            v0[e] = act == 1 ? v0[e] * s0 : s0; v1[e] = act == 1 ? v1[e] * s1 : s1; } }
                    pg8::u32x4 w; w.x = pg8::cvt_pk_bf16(v0[0], v0[1]); w.y = pg8::cvt_pk_bf16(v0[2], v0[3]); w.z = pg8::cvt_pk_bf16(v1[0], v1[1]); w.w = pg8::cvt_pk_bf16(v1[2], v1[3]);
                    *(pg8::u32x4*)(rowp + bj * 128) = w; }
                asm volatile("" ::: "memory"); }
    }
};
struct EpiP1T {
    static constexpr bool PERM = false, TRANS = true, HAS_MID = false;
    const float* bias; bf16 *HT, *ZHT;
    __device__ __forceinline__ void operator()(const pg8::f32x4 (&acc)[2][2][4][2], const pg8::Unit& u, int wr, int wc, int fr, int fq) const {
        const int pn = u.pn; const bool z = pn >= 12; bf16* base = z ? ZHT : HT;
        const int c0 = (z ? pn - 12 : pn) * 256 + wc * 32 + fr, bc0 = pn * 256 + wc * 32 + fr, r0 = u.pm * 256 + wr * 64 + 8 * fq;
#pragma unroll
        for (int bj = 0; bj < 2; ++bj)
#pragma unroll
            for (int n = 0; n < 2; ++n) {
                const float bv = bias[bc0 + bj * 128 + n * 16];
                bf16* colp = base + (size_t)(c0 + bj * 128 + n * 16) * M + r0;
#pragma unroll
                for (int ai = 0; ai < 2; ++ai)
#pragma unroll
                    for (int mp = 0; mp < 2; ++mp) { pg8::f32x4 v0 = acc[ai][bj][2 * mp][n] + bv, v1 = acc[ai][bj][2 * mp + 1][n] + bv;
                        if (z) {
#pragma unroll
                            for (int e = 0; e < 4; ++e) { v0[e] = v0[e] * __builtin_amdgcn_rcpf(1.0f + __expf(-v0[e])); v1[e] = v1[e] * __builtin_amdgcn_rcpf(1.0f + __expf(-v1[e])); } }
                        pg8::u32x4 w; w.x = pg8::cvt_pk_bf16(v0[0], v0[1]); w.y = pg8::cvt_pk_bf16(v0[2], v0[3]); w.z = pg8::cvt_pk_bf16(v1[0], v1[1]); w.w = pg8::cvt_pk_bf16(v1[2], v1[3]);
                        *(pg8::u32x4*)(colp + ai * 128 + mp * 32) = w; }
            }
    }
};
constexpr int CV_CS = 8256;
constexpr int CV_FC = 0;
constexpr int CV_RS = 4624;
constexpr int CV_U = 8 * CV_CS;
constexpr int CV_GATE = CV_U + 8 * CV_RS;
constexpr int CV_END = CV_GATE + 8 * 2048 * 2;
static_assert(CV_END <= LDSCTL_OFF, "conv LDS map");
struct __attribute__((packed, aligned(2))) U16B { v4u v; };

__device__ __forceinline__ void conv3_8(const v4u e, float lft, float rgt, float w0, float w1, float w2, float bb, float (&o)[8]) {
    float f[10]; f[0] = lft; f[9] = rgt;
    f[1] = bflo(e.x); f[2] = bfhi(e.x); f[3] = bflo(e.y); f[4] = bfhi(e.y); f[5] = bflo(e.z); f[6] = bfhi(e.z); f[7] = bflo(e.w); f[8] = bfhi(e.w);
#pragma unroll
    for (int j = 0; j < 8; ++j) o[j] = w0 * f[j] + w1 * f[j + 1] + w2 * f[j + 2] + bb;
}
__device__ __forceinline__ void conv_channel(const Args& a, LAS unsigned char* lds, int c, int tid, int wave, int lane) {
    unsigned char* ws = a.ws;
    const bf16* HT = (const bf16*)(ws + WS_HT); const bf16* ZHT = (const bf16*)(ws + WS_ZHT); const bf16* Gs = (const bf16*)(ws + WS_GS); bf16* YHT = (bf16*)(ws + WS_YHT);
    const CAS float* cw = as_const(a.conv_w); const CAS float* cb = as_const(a.conv_b);
    const float w00 = cw[c], w01 = cw[3072 + c], w02 = cw[6144 + c], b0 = cb[c];
    const float w10 = cw[1024 + c], w11 = cw[3072 + 1024 + c], w12 = cw[6144 + 1024 + c], b1 = cb[1024 + c];
    const float w20 = cw[2048 + c], w21 = cw[3072 + 2048 + c], w22 = cw[6144 + 2048 + c], b2 = cb[2048 + c];
    const bf16* h0 = HT + (size_t)c * M; const bf16* h1 = HT + (size_t)(1024 + c) * M; const bf16* h2 = HT + (size_t)(2048 + c) * M; const bf16* zp = ZHT + (size_t)c * M;
#pragma unroll 1
    for (int j = 0; j < 4; ++j) {
        int q = tid + 512 * j; asm volatile("" : "+v"(q));
        const int b = q >> 8, p0 = (q & 255) * 8, o = b * 2048 + p0;
        const v4u e0 = *(const GAS v4u*)(h0 + o), e1 = *(const GAS v4u*)(h1 + o), e2 = *(const GAS v4u*)(h2 + o), zz = *(const GAS v4u*)(zp + o);
        float l0 = 0.f, l1 = 0.f, l2 = 0.f, r0 = 0.f, r1 = 0.f, r2 = 0.f;
        if (p0 != 0) { l0 = bf2f(h0[o - 1]); l1 = bf2f(h1[o - 1]); l2 = bf2f(h2[o - 1]); }
        if (p0 != 2040) { r0 = bf2f(h0[o + 8]); r1 = bf2f(h1[o + 8]); r2 = bf2f(h2[o + 8]); }
        float x0[8], x1[8], vv[8];
        conv3_8(e0, l0, r0, w00, w01, w02, b0, x0); conv3_8(e1, l1, r1, w10, w11, w12, b1, x1); conv3_8(e2, l2, r2, w20, w21, w22, b2, vv);
        const float z[8] = {bflo(zz.x), bfhi(zz.x), bflo(zz.y), bfhi(zz.y), bflo(zz.z), bfhi(zz.z), bflo(zz.w), bfhi(zz.w)};
        v4u uo, go;
        uo.x = pk2(vv[0] * x1[0], vv[1] * x1[1]); uo.y = pk2(vv[2] * x1[2], vv[3] * x1[3]); uo.z = pk2(vv[4] * x1[4], vv[5] * x1[5]); uo.w = pk2(vv[6] * x1[6], vv[7] * x1[7]);
        go.x = pk2(x0[0] * z[0], x0[1] * z[1]); go.y = pk2(x0[2] * z[2], x0[3] * z[3]); go.z = pk2(x0[4] * z[4], x0[5] * z[5]); go.w = pk2(x0[6] * z[6], x0[7] * z[7]);
        *(LAS v4u*)(lds + CV_U + b * CV_RS + 192 + p0 * 2) = uo;
        *(LAS v4u*)(lds + CV_GATE + o * 2) = go;
    }
    {
        const bf16* grow = Gs + (size_t)c * GS_LD + 8 + 8 * tid;
#pragma unroll
        for (int s = 0; s < 8; ++s) { const v4u v = ((const U16B*)(grow - s))->v; *(LAS v4u*)(lds + CV_FC + s * CV_CS + 16 * tid) = v; }
    }
    LDS_WAIT(); __syncthreads();
    const int r = lane & 31, h = lane >> 5, s = r & 7;
    f32x16 acc0, acc1;
#pragma unroll
    for (int i = 0; i < 16; ++i) { acc0[i] = 0.f; acc1[i] = 0.f; }
    {
        const LAS unsigned char* pa = lds + CV_FC + s * CV_CS + 2 * (8 * h - (r - s) + 2048) - 256 * (2 * wave);
        const LAS unsigned char* pb = lds + CV_U + (r >> 2) * CV_RS + 2 * (96 + 32 * (r & 3) + 8 * h);
#pragma unroll 2
        for (int K0 = -6; K0 < 128; ++K0) {
            const bf16x8 Bf = *(const LAS bf16x8*)(pb + 32 * K0);
            const bf16x8 A0 = *(const LAS bf16x8*)(pa + 32 * K0);
            const bf16x8 A1 = *(const LAS bf16x8*)(pa + 32 * K0 - 256);
            acc0 = __builtin_amdgcn_mfma_f32_32x32x16_bf16(A0, Bf, acc0, 0, 0, 0);
            acc1 = __builtin_amdgcn_mfma_f32_32x32x16_bf16(A1, Bf, acc1, 0, 0, 0);
        }
    }
#pragma unroll
    for (int tt = 0; tt < 2; ++tt) {
        const int pos0 = 32 * (4 * (2 * wave + tt) + (r & 3)) + 4 * h;
#pragma unroll
        for (int g4 = 0; g4 < 4; ++g4) {
            LAS v2u* gp = (LAS v2u*)(lds + CV_GATE + ((r >> 2) * 2048 + pos0 + 8 * g4) * 2);
            const v2u gw = *gp; v2u o;
            const float y0 = tt ? acc1[4 * g4 + 0] : acc0[4 * g4 + 0], y1 = tt ? acc1[4 * g4 + 1] : acc0[4 * g4 + 1], y2 = tt ? acc1[4 * g4 + 2] : acc0[4 * g4 + 2], y3 = tt ? acc1[4 * g4 + 3] : acc0[4 * g4 + 3];
            o.x = pk2(y0 * bflo(gw.x), y1 * bfhi(gw.x)); o.y = pk2(y2 * bflo(gw.y), y3 * bfhi(gw.y));
            *gp = o;
        }
    }
    LDS_WAIT(); __syncthreads();
    {
        bf16* yo = YHT + (size_t)c * M;
#pragma unroll
        for (int j = 0; j < 4; ++j) { const int q = tid + 512 * j; *(GAS v4u*)(yo + q * 8) = *(const LAS v4u*)(lds + CV_GATE + q * 16); }
    }
    LDS_WAIT(); __syncthreads();
}
__device__ __forceinline__ void conv_zero_pads(LAS unsigned char* lds, int tid) {
    if (tid < 192) { const int b = tid / 24, k = tid % 24; const int off = CV_U + b * CV_RS + (k < 12 ? k * 16 : 2 * (96 + 2048) + (k - 12) * 16); *(LAS v4u*)(lds + off) = (v4u){0u, 0u, 0u, 0u}; }
}

constexpr int PU_RS = 528;
static_assert(256 * PU_RS <= LDSCTL_OFF, "pool LDS map");
__device__ __forceinline__ void pool_unit(const Args& a, LAS unsigned char* lds, int pm, int g, int tid, int wave, int lane) {
    unsigned char* ws = a.ws;
    const bf16* PL = (const bf16*)(ws + WS_PL); bf16* YP = (bf16*)(ws + WS_ZP); const bf16* WgT = (const bf16*)(ws + WS_WGT) + (size_t)g * 65536;
    {
        const int col = tid & 255, half = tid >> 8, hw = 1 << g;
        const int lbase = (pm & 7) * 256 + half * 128;
        const bf16* xp = PL + (size_t)(pm * 256 + half * 128 - lbase) * 1024 + 256 * g + col;
        float ssum = 0.f;
        for (int q = lbase - hw; q < lbase + hw; ++q) if (q >= 0 && q < SEQ) ssum += bf2f(xp[(size_t)q * 1024]);
        LAS unsigned short* pt = (LAS unsigned short*)(lds + (half * 128) * PU_RS + col * 2);
#pragma unroll 4
        for (int i = 0; i < 128; ++i) {
            const int l = lbase + i;
            const int lo = max(l - hw, 0), hi = min(l + hw, SEQ);
            const float xc = bf2f(xp[(size_t)l * 1024]);
            pt[i * (PU_RS / 2)] = (unsigned short)f2bf(ssum / (float)(hi - lo) - xc);
            if (l + hw < SEQ) ssum += bf2f(xp[(size_t)(l + hw) * 1024]);
            if (l - hw >= 0) ssum -= bf2f(xp[(size_t)(l - hw) * 1024]);
        }
    }
    LDS_WAIT(); __syncthreads();
    const int r = lane & 31, h = lane >> 5, wr = wave >> 1, wc = wave & 1;
    f32x16 acc[2][4];
#pragma unroll
    for (int mi = 0; mi < 2; ++mi)
#pragma unroll
        for (int ni = 0; ni < 4; ++ni)
#pragma unroll
            for (int i = 0; i < 16; ++i) acc[mi][ni][i] = 0.f;
    {
        const LAS unsigned char* pa = lds + (64 * wr + r) * PU_RS + 16 * h;
        const bf16* pb = WgT + (size_t)(128 * wc + r) * 256 + 8 * h;
#pragma unroll 2
        for (int kk = 0; kk < 16; ++kk) {
            bf16x8 A[2], B[4];
#pragma unroll
            for (int mi = 0; mi < 2; ++mi) A[mi] = *(const LAS bf16x8*)(pa + mi * 32 * PU_RS + kk * 32);
#pragma unroll
            for (int ni = 0; ni < 4; ++ni) B[ni] = *(const GAS bf16x8*)(pb + ni * 32 * 256 + kk * 16);
#pragma unroll
            for (int mi = 0; mi < 2; ++mi)
#pragma unroll
                for (int ni = 0; ni < 4; ++ni) acc[mi][ni] = __builtin_amdgcn_mfma_f32_32x32x16_bf16(A[mi], B[ni], acc[mi][ni], 0, 0, 0);
        }
    }
#pragma unroll
    for (int ni = 0; ni < 4; ++ni) {
        const int nn = 256 * g + 128 * wc + 32 * ni + r;
        const float pb_ = a.pool_b[nn], ps_ = a.pool_s[nn];
#pragma unroll
        for (int mi = 0; mi < 2; ++mi)
#pragma unroll
            for (int i = 0; i < 16; ++i) {
                const int m = 256 * pm + 64 * wr + 32 * mi + (i & 3) + 8 * (i >> 2) + 4 * h;
                bf16* yp = YP + (size_t)m * 1024 + nn;
                *yp = (bf16)f2bf((acc[mi][ni][i] + pb_) * ps_ * bf2f(*yp));
            }
    }
    LDS_WAIT(); __syncthreads();
}

constexpr int TR_RS = 260;
__device__ __forceinline__ void transpose_tile(const Args& a, LAS unsigned char* lds, int tile, int tid) {
    unsigned char* ws = a.ws;
    const bf16* YHT = (const bf16*)(ws + WS_YHT); bf16* YH = (bf16*)(ws + WS_YH);
    const int c0 = 64 * (tile & 15), m0 = 128 * (tile >> 4);
#pragma unroll
    for (int j = 0; j < 2; ++j) { const int q = tid + 512 * j, row = q >> 4, ch = q & 15;
        const v4u v = *(const GAS v4u*)(YHT + (size_t)(c0 + row) * M + m0 + 8 * ch);
        LAS unsigned* d = (LAS unsigned*)(lds + row * TR_RS + ch * 16); d[0] = v.x; d[1] = v.y; d[2] = v.z; d[3] = v.w; }
    LDS_WAIT(); __syncthreads();
#pragma unroll
    for (int j = 0; j < 2; ++j) { const int q = tid + 512 * j, mrow = q >> 3, cc8 = q & 7;
        const LAS unsigned short* s = (const LAS unsigned short*)(lds + (8 * cc8) * TR_RS + mrow * 2);
        v4u o;
        o.x = (unsigned)s[0 * (TR_RS / 2)] | ((unsigned)s[1 * (TR_RS / 2)] << 16); o.y = (unsigned)s[2 * (TR_RS / 2)] | ((unsigned)s[3 * (TR_RS / 2)] << 16);
        o.z = (unsigned)s[4 * (TR_RS / 2)] | ((unsigned)s[5 * (TR_RS / 2)] << 16); o.w = (unsigned)s[6 * (TR_RS / 2)] | ((unsigned)s[7 * (TR_RS / 2)] << 16);
        *(GAS v4u*)(YH + (size_t)(m0 + mrow) * 1024 + c0 + 8 * cc8) = o; }
    LDS_WAIT(); __syncthreads();
}

struct EpiMg {
    static constexpr bool PERM = true, TRANS = false, HAS_MID = true;
    const bf16* GT; bf16* MG;
    __device__ __forceinline__ void mid(pg8::f32x4 (&acc)[2][2][4][2], const pg8::Unit& u, int wr, int wc, int fr, int fq) const {
        const int row0 = u.pm * 256 + wr * 64 + fr, col0 = u.pn * 256 + wc * 32 + 8 * fq;
#pragma unroll
        for (int ai = 0; ai < 2; ++ai)
#pragma unroll
            for (int m = 0; m < 4; ++m) { const bf16* gp = GT + (size_t)(row0 + ai * 128 + m * 16) * 2048 + col0;
#pragma unroll
                for (int bj = 0; bj < 2; ++bj) { const v4u a0 = *(const GAS v4u*)(gp + bj * 128), a1 = *(const GAS v4u*)(gp + 1024 + bj * 128);
                    const float n0[8] = {bflo(a0.x), bfhi(a0.x), bflo(a0.y), bfhi(a0.y), bflo(a0.z), bfhi(a0.z), bflo(a0.w), bfhi(a0.w)};
                    const float d0[8] = {bflo(a1.x), bfhi(a1.x), bflo(a1.y), bfhi(a1.y), bflo(a1.z), bfhi(a1.z), bflo(a1.w), bfhi(a1.w)};
#pragma unroll
                    for (int e = 0; e < 4; ++e) { acc[ai][bj][m][0][e] *= n0[e] * __builtin_amdgcn_rcpf(d0[e]); acc[ai][bj][m][1][e] *= n0[4 + e] * __builtin_amdgcn_rcpf(d0[4 + e]); } }
                asm volatile("" ::: "memory"); }
    }
    __device__ __forceinline__ void operator()(const pg8::f32x4 (&acc)[2][2][4][2], const pg8::Unit& u, int wr, int wc, int fr, int fq) const {
        const int row0 = u.pm * 256 + wr * 64 + fr, col0 = u.pn * 256 + wc * 32 + 8 * fq;
#pragma unroll
        for (int ai = 0; ai < 2; ++ai)
#pragma unroll
            for (int m = 0; m < 4; ++m) { const size_t ro = (size_t)(row0 + ai * 128 + m * 16);
#pragma unroll
                for (int bj = 0; bj < 2; ++bj) { const v4u a1 = *(const GAS v4u*)(GT + ro * 2048 + 1024 + col0 + bj * 128);
                    const pg8::f32x4 v0 = acc[ai][bj][m][0], v1 = acc[ai][bj][m][1];
                    pg8::u32x4 w; w.x = pg8::cvt_pk_bf16(v0[0] * bflo(a1.x), v0[1] * bfhi(a1.x)); w.y = pg8::cvt_pk_bf16(v0[2] * bflo(a1.y), v0[3] * bfhi(a1.y));
                    w.z = pg8::cvt_pk_bf16(v1[0] * bflo(a1.z), v1[1] * bfhi(a1.z)); w.w = pg8::cvt_pk_bf16(v1[2] * bflo(a1.w), v1[3] * bfhi(a1.w));
                    *(pg8::u32x4*)(MG + ro * 1024 + col0 + bj * 128) = w; }
                asm volatile("" ::: "memory"); }
    }
};
struct EpiOutF {
    static constexpr bool PERM = false, TRANS = false, HAS_MID = false;
    const float* x; float* out;
    __device__ __forceinline__ void operator()(const pg8::f32x4 (&acc)[2][2][4][2], const pg8::Unit& u, int wr, int wc, int fr, int fq) const {
        const int row0 = u.pm * 256 + wr * 64 + fr, col0 = u.pn * 256 + wc * 32 + 4 * fq;
#pragma unroll
        for (int ai = 0; ai < 2; ++ai)
#pragma unroll
            for (int m = 0; m < 4; ++m) { const size_t off = (size_t)(row0 + ai * 128 + m * 16) * 1024 + col0;
#pragma unroll
                for (int bj = 0; bj < 2; ++bj)
#pragma unroll
                    for (int n = 0; n < 2; ++n) *(pg8::f32x4*)(out + off + bj * 128 + n * 16) = *(const pg8::f32x4*)(x + off + bj * 128 + n * 16) + acc[ai][bj][m][n];
                asm volatile("" ::: "memory"); }
    }
};
__device__ __forceinline__ void final_norm_row(float* row, const float* g, int lane) {
    GAS f32x4* xr = (GAS f32x4*)row + lane;
    f32x4 v[4]; float s = 0.f;
#pragma unroll
    for (int j = 0; j < 4; ++j) { v[j] = xr[64 * j]; s += (v[j].x * v[j].x + v[j].y * v[j].y) + (v[j].z * v[j].z + v[j].w * v[j].w); }
    const float rstd = 1.0f / sqrtf(wave_sum(s) * (1.0f / DM) + 1e-6f);
#pragma unroll
    for (int j = 0; j < 4; ++j) { const f32x4 gg = ((const GAS f32x4*)g)[lane + 64 * j]; xr[64 * j] = v[j] * rstd * gg; }
}

__global__ void k_transpose_b(const bf16* __restrict__ S, int R, int C, bf16* __restrict__ D) {
    __shared__ bf16 tile[32][34];
    const int c0 = blockIdx.x * 32, r0 = blockIdx.y * 32, tx = threadIdx.x, ty = threadIdx.y;
#pragma unroll
    for (int i = 0; i < 4; ++i) tile[ty + 8 * i][tx] = S[(size_t)(r0 + ty + 8 * i) * C + c0 + tx];
    __syncthreads();
#pragma unroll
    for (int i = 0; i < 4; ++i) D[(size_t)(c0 + ty + 8 * i) * R + r0 + tx] = tile[tx][ty + 8 * i];
}
template <class Epi>
__global__ __launch_bounds__(256) void k_gemm_simple(const bf16* __restrict__ A, int lda, size_t aoffz, const bf16* __restrict__ Bt, int ldb, size_t boffz, int K, Epi epi) {
    const int wave = threadIdx.x >> 6, lane = threadIdx.x & 63, r = lane & 31, h = lane >> 5;
    const int m0 = blockIdx.y * 64 + (wave >> 1) * 32, n0 = blockIdx.x * 64 + (wave & 1) * 32, z = blockIdx.z;
    const bf16* ap = A + aoffz * z + (size_t)(m0 + r) * lda + 8 * h;
    const bf16* bp = Bt + boffz * z + (size_t)(n0 + r) * ldb + 8 * h;
    f32x16 acc;
#pragma unroll
    for (int i = 0; i < 16; ++i) acc[i] = 0.f;
    for (int k0 = 0; k0 < K; k0 += 16) {
        const bf16x8 a = *(const bf16x8*)(ap + k0), b = *(const bf16x8*)(bp + k0);
        acc = __builtin_amdgcn_mfma_f32_32x32x16_bf16(a, b, acc, 0, 0, 0);
    }
#pragma unroll
    for (int i = 0; i < 16; ++i) epi(m0 + (i & 3) + 8 * (i >> 2) + 4 * h, n0 + r, z, acc[i]);
}
struct Epi1 { const float* b_in; bf16 *HT, *ZHT, *PL, *ZP, *GT;
    __device__ __forceinline__ void operator()(int m, int n, int, float v) const {
        v += b_in[n];
        if (n < 3072) HT[(size_t)n * M + m] = f2bf(v);
        else if (n < 4096) ZHT[(size_t)(n - 3072) * M + m] = f2bf(silu_f(v));
        else if (n < 5120) PL[(size_t)m * 1024 + (n - 4096)] = f2bf(v);
        else if (n < 6144) ZP[(size_t)m * 1024 + (n - 5120)] = f2bf(silu_f(v));
        else GT[(size_t)m * 2048 + (n - 6144)] = f2bf(sigm_f(v));
    } };
struct EpiPool { const float *pb, *ps; bf16* YP;
    __device__ __forceinline__ void operator()(int m, int n, int g, float v) const {
        const int nn = 256 * g + n; const size_t o = (size_t)m * 1024 + nn;
        YP[o] = f2bf((v + pb[nn]) * ps[nn] * bf2f(YP[o]));
    } };
struct EpiM1 { const bf16* GT; float* MGF;
    __device__ __forceinline__ void operator()(int m, int n, int, float v) const { MGF[(size_t)m * 1024 + n] = v * bf2f(GT[(size_t)m * 2048 + n]); } };
struct EpiM2 { const bf16* GT; const float* MGF; bf16* MG;
    __device__ __forceinline__ void operator()(int m, int n, int, float v) const { const size_t o = (size_t)m * 1024 + n; MG[o] = f2bf(MGF[o] + v * bf2f(GT[(size_t)m * 2048 + 1024 + n])); } };
struct EpiOut { const float* x; float* out;
    __device__ __forceinline__ void operator()(int m, int n, int, float v) const { const size_t o = (size_t)m * 1024 + n; out[o] = x[o] + v; } };

__global__ __launch_bounds__(256) void k_conv_naive(const bf16* __restrict__ HT, const bf16* __restrict__ ZHT, const bf16* __restrict__ Gs,
                                                    const float* __restrict__ cw, const float* __restrict__ cb, bf16* __restrict__ YHT) {
    __shared__ float g[4096];
    __shared__ float u[4][2048];
    const int c = blockIdx.x, bh = blockIdx.y, tid = threadIdx.x;
    for (int x = tid; x < 4096; x += 256) g[x] = bf2f(Gs[(size_t)c * GS_LD + 8 + x]);
    const float w10 = cw[0 * 3072 + 1024 + c], w11 = cw[1 * 3072 + 1024 + c], w12 = cw[2 * 3072 + 1024 + c], b1 = cb[1024 + c];
    const float w20 = cw[0 * 3072 + 2048 + c], w21 = cw[1 * 3072 + 2048 + c], w22 = cw[2 * 3072 + 2048 + c], b2 = cb[2048 + c];
    const float w00 = cw[0 * 3072 + c], w01 = cw[1 * 3072 + c], w02 = cw[2 * 3072 + c], b0 = cb[c];
    const bf16* h0 = HT + (size_t)c * M; const bf16* h1 = HT + (size_t)(1024 + c) * M; const bf16* h2 = HT + (size_t)(2048 + c) * M;
    for (int e = tid; e < 4 * 2048; e += 256) {
        const int b = e >> 11, l = e & 2047; const size_t o = (size_t)(bh * 4 + b) * 2048 + l;
        const float x1 = w10 * (l > 0 ? bf2f(h1[o - 1]) : 0.f) + w11 * bf2f(h1[o]) + w12 * (l < 2047 ? bf2f(h1[o + 1]) : 0.f) + b1;
        const float vv = w20 * (l > 0 ? bf2f(h2[o - 1]) : 0.f) + w21 * bf2f(h2[o]) + w22 * (l < 2047 ? bf2f(h2[o + 1]) : 0.f) + b2;
        u[b][l] = vv * x1;
    }
    __syncthreads();
    float acc[8][4];
#pragma unroll
    for (int ii = 0; ii < 8; ++ii)
#pragma unroll
        for (int b = 0; b < 4; ++b) acc[ii][b] = 0.f;
    for (int k = 0; k < 2048; ++k) {
        float uv[4];
#pragma unroll
        for (int b = 0; b < 4; ++b) uv[b] = u[b][k];
#pragma unroll
        for (int ii = 0; ii < 8; ++ii) { const float gv = g[k - (tid + 256 * ii) + 2048];
#pragma unroll
            for (int b = 0; b < 4; ++b) acc[ii][b] += gv * uv[b]; }
    }
#pragma unroll
    for (int ii = 0; ii < 8; ++ii)
#pragma unroll
        for (int b = 0; b < 4; ++b) {
            const int l = tid + 256 * ii; const size_t o = (size_t)(bh * 4 + b) * 2048 + l;
            const float x0 = w00 * (l > 0 ? bf2f(h0[o - 1]) : 0.f) + w01 * bf2f(h0[o]) + w02 * (l < 2047 ? bf2f(h0[o + 1]) : 0.f) + b0;
            YHT[(size_t)c * M + o] = f2bf(acc[ii][b] * x0 * bf2f(ZHT[(size_t)c * M + o]));
        }
}
__global__ __launch_bounds__(256) void k_pool_naive(const bf16* __restrict__ PL, bf16* __restrict__ P) {
    const size_t idx = (size_t)blockIdx.x * 256 + threadIdx.x; const int c = (int)(idx & 1023), m = (int)(idx >> 10), l = m & 2047, g = c >> 8, w = 2 << g;
    const int lo = max(l - w / 2, 0), hi = min(l + w / 2, SEQ);
    float s = 0.f;
    for (int q = lo; q < hi; ++q) s += bf2f(PL[(size_t)(m - l + q) * 1024 + c]);
    P[idx] = f2bf(s / (float)(hi - lo) - bf2f(PL[idx]));
}
__global__ __launch_bounds__(256) void k_final_norm(float* __restrict__ out, const float* __restrict__ g) {
    const int wave = threadIdx.x >> 6, lane = threadIdx.x & 63, row = blockIdx.x * 4 + wave;
    f32x4* xr = (f32x4*)(out + (size_t)row * DM) + lane;
    f32x4 v[4]; float s = 0.f;
#pragma unroll
    for (int j = 0; j < 4; ++j) { v[j] = xr[64 * j]; s += (v[j].x * v[j].x + v[j].y * v[j].y) + (v[j].z * v[j].z + v[j].w * v[j].w); }
    const float rstd = 1.0f / sqrtf(wave_sum(s) * (1.0f / DM) + 1e-6f);
#pragma unroll
    for (int j = 0; j < 4; ++j) { const f32x4 gg = ((const f32x4*)g)[lane + 64 * j]; xr[64 * j] = v[j] * rstd * gg; }
}

__global__ void __launch_bounds__(NWAVES * 64, 2) mega(Args a) {
    extern __shared__ __attribute__((aligned(16))) unsigned char lds_raw[];
    LAS unsigned char* lds = (LAS unsigned char*)lds_raw;
    const int tid = threadIdx.x, lane = tid & 63, wave = __builtin_amdgcn_readfirstlane(tid >> 6);
    const int G = gridDim.x, bx = blockIdx.x, vcu = (G % 8 == 0) ? (bx % 8) * (G / 8) + bx / 8 : bx;
    const int gw = vcu * NWAVES + wave, NGW = G * NWAVES;
    volatile LAS unsigned* MISC = (volatile LAS unsigned*)(lds + MISC_OFF);
    unsigned char* ws = a.ws;
    gu32* ctl = (gu32*)(ws + WS_CTL);
    for (int u = tid; u < (LDS_BYTES - LDSCTL_OFF) / 4; u += NWAVES * 64) ((LAS unsigned*)(lds + LDSCTL_OFF))[u] = 0u;
    __syncthreads();
    XcdBarrier bar = xcd_barrier_post((unsigned*)(ctl + CW_BAR) + a.li * XCD_BAR_WORDS, MISC + 8);
    const int lo = a.ph_lo, hi = a.ph_hi;
#define IN(k) (lo <= (k) && (k) < hi)
#define BOTH(k) (IN(k) && IN((k) + 1))
    bf16 *WcT = (bf16*)(ws + WS_WCT), *WoT = (bf16*)(ws + WS_WOT), *Gs = (bf16*)(ws + WS_GS), *XN = (bf16*)(ws + WS_XN),
         *WinT = (bf16*)(ws + WS_WINT), *HT = (bf16*)(ws + WS_HT), *YH = (bf16*)(ws + WS_YH), *ZHT = (bf16*)(ws + WS_ZHT), *MG = (bf16*)(ws + WS_MG),
         *PL = (bf16*)(ws + WS_PL), *ZP = (bf16*)(ws + WS_ZP), *GT = (bf16*)a.out;
    float* H3 = (float*)(ws + WS_H3);

    if (IN(0)) { p0_prologue(a, lds, gw, NGW, wave, lane); if (BOTH(0)) xcd_barrier(bar); }
    if (IN(1)) {
        for (int it = gw; it < 2048; it += NGW) gs_item(a, H3, Gs, it, lane);
        { pg8::Gemm g{XN, XN, WinT, DM, DM, M, 4096, DM, DM / 64}; pg8::StaticOrder S; S.init(M, 4096, G, bx);
          EpiP1T E{a.b_in, HT, ZHT};
          pg8::gemm_phase<EpiP1T, true, true, false>(lds + RING_OFF, g, S, E); }
        { pg8::Gemm g{XN, XN, WinT + (size_t)4096 * DM, DM, DM, M, 4096, DM, DM / 64}; pg8::StaticOrder S; S.init(M, 4096, G, bx);
          EpiP1N E{a.b_in, PL, GT, 16};
          pg8::gemm_phase<EpiP1N, true, true, false>(lds + RING_OFF, g, S, E); }
        if (BOTH(1)) xcd_barrier(bar);
    }
    if (IN(2)) {
        conv_zero_pads(lds, tid);
        for (int c = vcu; c < 1024; c += G) conv_channel(a, lds, c, tid, wave, lane);
        for (int un = vcu; un < 256; un += G) pool_unit(a, lds, un >> 2, un & 3, tid, wave, lane);
        if (BOTH(2)) xcd_barrier(bar);
    }
    if (IN(3)) {
        for (int t = vcu; t < 2048; t += G) transpose_tile(a, lds, t, tid);
        if (BOTH(3)) xcd_barrier(bar);
    }
    if (IN(4)) {
        pg8::Gemm g{YH, ZP, WcT, DM, 2048, M, DM, 2048, 16}; pg8::StaticOrder S; S.init(M, DM, G, bx);
        EpiMg E{GT, MG};
        pg8::gemm_phase<EpiMg, false, true, true>(lds + RING_OFF, g, S, E);
        if (BOTH(4)) xcd_barrier(bar);
    }
    if (IN(5)) {
        pg8::Gemm g{MG, MG, WoT, DM, DM, M, DM, DM, 16}; pg8::StaticOrder S; S.init(M, DM, G, bx);
        EpiOutF E{a.x, a.out};
        pg8::gemm_phase<EpiOutF, false, true, false>(lds + RING_OFF, g, S, E);
        if (BOTH(5)) xcd_barrier(bar);
    }
    if (IN(6)) {
        for (int m = gw; m < M; m += NGW) { int ln = lane; asm volatile("" : "+v"(ln)); final_norm_row(a.out + (size_t)m * DM, a.g_fin, ln); }
    }
#undef IN
#undef BOTH
}

#ifndef MEGA_PH
#define MEGA_PH 7
#endif
extern "C" void kernel_launch(void* const* d_in, const int* in_sizes, int n_in, void* d_out, int out_size, void* d_ws, size_t ws_size, hipStream_t stream) {
    static int grid = 0;
    if (grid == 0) {
        if (n_in != 22 || out_size != M * DM || ws_size < WS_END) { fprintf(stderr, "kernel_launch: unexpected shapes (n_in %d out %d ws %zu)\n", n_in, out_size, ws_size); grid = -1; return; }
        int dev = 0, cus = 0;
        if (hipGetDevice(&dev) != hipSuccess || hipDeviceGetAttribute(&cus, hipDeviceAttributeMultiprocessorCount, dev) != hipSuccess) { grid = -1; return; }
        if (hipFuncSetAttribute((const void*)mega, hipFuncAttributeMaxDynamicSharedMemorySize, LDS_BYTES) != hipSuccess) { fprintf(stderr, "kernel_launch: hipFuncSetAttribute failed\n"); grid = -1; return; }
        grid = cus;
    }
    if (grid < 0) return;
    unsigned char* ws = (unsigned char*)d_ws; float* out = (float*)d_out;
    (void)hipMemsetAsync(ws + WS_CTL, 0, CTL_ZERO_BYTES, stream);
    Args a{};
    a.x = (const float*)d_in[0]; a.g_norm = (const float*)d_in[1]; a.w_in = (const float*)d_in[2]; a.b_in = (const float*)d_in[3]; a.conv_w = (const float*)d_in[4]; a.conv_b = (const float*)d_in[5];
    a.fw1 = (const float*)d_in[6]; a.fb1 = (const float*)d_in[7]; a.fw2 = (const float*)d_in[8]; a.fb2 = (const float*)d_in[9]; a.fw3 = (const float*)d_in[10]; a.fb3 = (const float*)d_in[11];
    a.fw4 = (const float*)d_in[12]; a.ffreq = (const float*)d_in[13]; a.hyd = (const float*)d_in[14]; a.w_ho = (const float*)d_in[15]; a.pool_w = (const float*)d_in[16]; a.pool_b = (const float*)d_in[17];
    a.pool_s = (const float*)d_in[18]; a.w_po = (const float*)d_in[19]; a.w_out = (const float*)d_in[20]; a.g_fin = (const float*)d_in[21];
    a.out = out; a.ws = ws; a.ph_lo = 0; a.ph_hi = MEGA_PH; a.li = 0; a.pad = 0;
    hipLaunchKernelGGL(mega, dim3(grid), dim3(NWAVES * 64), LDS_BYTES, stream, a);
#if MEGA_PH < 7
    bf16 *WcT = (bf16*)(ws + WS_WCT), *WoT = (bf16*)(ws + WS_WOT), *WgT = (bf16*)(ws + WS_WGT), *Gs = (bf16*)(ws + WS_GS), *YHT = (bf16*)(ws + WS_YHT),
         *HT = (bf16*)(ws + WS_HT), *YH = (bf16*)(ws + WS_YH), *POOLED = (bf16*)(ws + WS_POOLED), *ZHT = (bf16*)(ws + WS_ZHT), *MG = (bf16*)(ws + WS_MG),
         *PL = (bf16*)(ws + WS_PL), *ZP = (bf16*)(ws + WS_ZP), *GT = (bf16*)d_out;
    float* MGF = (float*)(ws + WS_MGF);
    if (MEGA_PH < 3) { k_conv_naive<<<dim3(1024, 2), 256, 0, stream>>>(HT, ZHT, Gs, a.conv_w, a.conv_b, YHT); }
    if (MEGA_PH < 4) k_transpose_b<<<dim3(M / 32, 1024 / 32), dim3(32, 8), 0, stream>>>(YHT, 1024, M, YH);
    if (MEGA_PH < 3) { k_pool_naive<<<(unsigned)((size_t)M * 1024 / 256), 256, 0, stream>>>(PL, POOLED);
        k_gemm_simple<EpiPool><<<dim3(256 / 64, M / 64, 4), 256, 0, stream>>>(POOLED, 1024, 256, WgT, 256, 65536, 256, EpiPool{a.pool_b, a.pool_s, ZP}); }
    if (MEGA_PH < 5) { k_gemm_simple<EpiM1><<<dim3(DM / 64, M / 64, 1), 256, 0, stream>>>(YH, 1024, 0, WcT, 2048, 0, 1024, EpiM1{GT, MGF});
        k_gemm_simple<EpiM2><<<dim3(DM / 64, M / 64, 1), 256, 0, stream>>>(ZP, 1024, 0, WcT + 1024, 2048, 0, 1024, EpiM2{GT, MGF, MG}); }
    if (MEGA_PH < 6) k_gemm_simple<EpiOut><<<dim3(DM / 64, M / 64, 1), 256, 0, stream>>>(MG, 1024, 0, WoT, 1024, 0, 1024, EpiOut{a.x, out});
    if (MEGA_PH < 7) k_final_norm<<<M / 4, 256, 0, stream>>>(out, a.g_fin);
#endif
}
```

```cpp
#include <hip/hip_runtime.h>
#include <cstdio>
#include <cstdint>
namespace pg8 {
#define PG8_LAS __attribute__((address_space(3)))
typedef unsigned short bf16_t;
typedef short bf16x8 __attribute__((ext_vector_type(8)));
typedef float f32x4 __attribute__((ext_vector_type(4)));
typedef unsigned u32x4 __attribute__((ext_vector_type(4)));
typedef unsigned u32x2 __attribute__((ext_vector_type(2)));
constexpr int BM = 256, BK = 64, HALF = 128, HTB = HALF * BK * 2  , STAGE_BYTES = 8 * HTB, NXCD = 8, WGM = 8;

__host__ __device__ __forceinline__ int lds_byte(int r, int c) { const int st = (r >> 4) * 2 + (c >> 5), rr = r & 15, cc = c & 31, ob = rr * 64 + cc * 2; return st * 1024 + (ob ^ (((ob >> 9) & 1) << 5)); }
__host__ __device__ __forceinline__ void stage_rc(int b, int& R, int& C) { const int st = b / 1024, sb = b % 1024, swz = sb ^ (((sb >> 9) & 1) << 5); R = (st >> 1) * 16 + swz / 64; C = (st & 1) * 32 + (swz % 64) / 2; }
__host__ __device__ __forceinline__ int perm32(int rho) { const int n = rho >> 4, i = rho & 15; return 8 * (i >> 2) + 4 * n + (i & 3); }

struct Unit { int pm, pn; };
struct Gemm { const bf16_t* A; const bf16_t* A2; const bf16_t* Bt; int lda, ldb, M, N, K, nth; };

struct StaticOrder {
    int nM, nN, nwg, G, c;
    __host__ __device__ void init(int M, int N, int G_, int c_) { nM = M / BM; nN = N / BM; nwg = nM * nN; G = G_; c = c_; }
    __host__ __device__ bool next(int i, Unit& u) const {
        const long L = (long)i * G + c; if (L >= nwg) return false;
        int wgid = (int)L; { const int q = nwg / NXCD, r = nwg % NXCD, xcd = wgid % NXCD, off = wgid / NXCD; wgid = (xcd < r ? xcd * (q + 1) : r * (q + 1) + (xcd - r) * q) + off; }
        const int nig = WGM * nN, gid = wgid / nig, fm = gid * WGM, gsz = (nM - fm) < WGM ? (nM - fm) : WGM;
        u.pm = fm + ((wgid % nig) % gsz); u.pn = (wgid % nig) / gsz; return true;
    }
};
__device__ __forceinline__ unsigned cvt_pk_bf16(float lo, float hi) { unsigned r; asm volatile("v_cvt_pk_bf16_f32 %0, %1, %2" : "=v"(r) : "v"(lo), "v"(hi)); return r; }

template <class Epi, bool ALIGN_EPI, bool SP2, bool DUAL>
__device__ __forceinline__ void gemm_phase(PG8_LAS unsigned char* lds, const Gemm g, const StaticOrder& S, const Epi& E) {
    const int tid = threadIdx.x, wid = __builtin_amdgcn_readfirstlane(tid >> 6), lane = tid & 63, wr = wid >> 2, wc = wid & 3, fr = lane & 15, fq = lane >> 4;
    const int K = g.K, nt = K / BK, nth = g.nth;
    unsigned voffA[2], voffB[2];
#pragma unroll
    for (int i = 0; i < 2; ++i) { int R, C; stage_rc(tid * 16 + i * 8192, R, C); const int Rb = Epi::PERM ? ((R & ~31) + perm32(R & 31)) : R; const int Ra = Epi::TRANS ? ((R & ~31) + perm32(R & 31)) : R;
        voffA[i] = (unsigned)(Ra * g.lda + C) * 2u; voffB[i] = (unsigned)(Rb * g.ldb + C) * 2u; }
    const size_t kstep = (size_t)(BK * 2);
    const size_t hstepA = (size_t)HALF * g.lda * 2, hstepB = (size_t)HALF * g.ldb * 2;
    const size_t tstepA = 2 * hstepA, tstepB = 2 * hstepB;
    const long a2delta = DUAL ? ((const char*)g.A2 - (const char*)g.A) - (long)nth * (long)kstep : 0;
    const unsigned ldsw = (unsigned)wid * 1024u;
    const int aoff = lds_byte(wr * 64 + fr, fq * 8), boff = lds_byte(wc * 32 + fr, fq * 8);
#define PG8_SA(b, h) (((b) * 2 + (h)) * HTB)
#define PG8_SB(b, h) ((4 + (b) * 2 + (h)) * HTB)
#define PG8_STAGE(bufoff, gbase, voff) do { _Pragma("unroll") for (int _i = 0; _i < 2; ++_i) \
        __builtin_amdgcn_global_load_lds((const unsigned*)((const char*)(gbase) + (voff)[_i]), (PG8_LAS unsigned*)(lds + (bufoff) + ldsw + _i * 8192), 16, 0, 0); } while (0)
#define PG8_LDA(dst, b, h) do { _Pragma("unroll") for (int m = 0; m < 4; ++m) _Pragma("unroll") for (int k = 0; k < 2; ++k) dst[m][k] = *(const PG8_LAS bf16x8*)(lds + PG8_SA(b, h) + aoff + m * 2048 + k * 1024); } while (0)
#define PG8_LDB(dst, b, h) do { _Pragma("unroll") for (int n = 0; n < 2; ++n) _Pragma("unroll") for (int k = 0; k < 2; ++k) dst[n][k] = *(const PG8_LAS bf16x8*)(lds + PG8_SB(b, h) + boff + n * 2048 + k * 1024); } while (0)
#define PG8_MMA(ai, bj, At, Bt) do { __builtin_amdgcn_s_setprio(1); _Pragma("unroll") for (int m = 0; m < 4; ++m) _Pragma("unroll") for (int n = 0; n < 2; ++n) _Pragma("unroll") for (int k = 0; k < 2; ++k) \
        acc[ai][bj][m][n] = Epi::TRANS ? __builtin_amdgcn_mfma_f32_16x16x32_bf16(At[m][k], Bt[n][k], acc[ai][bj][m][n], 0, 0, 0) : __builtin_amdgcn_mfma_f32_16x16x32_bf16(Bt[n][k], At[m][k], acc[ai][bj][m][n], 0, 0, 0); __builtin_amdgcn_s_setprio(0); } while (0)
#define PG8_WAIT_V(n) asm volatile("s_waitcnt vmcnt(" #n ")" ::: "memory")
#define PG8_WAIT_L(n) asm volatile("s_waitcnt lgkmcnt(" #n ")" ::: "memory")
#define PG8_BAR __builtin_amdgcn_s_barrier()
#define PG8_SCHED __builtin_amdgcn_sched_barrier(0)
#define PG8_AT(base, tt) ((DUAL && (tt) >= nth) ? (base) + a2delta + (size_t)(tt) * kstep : (base) + (size_t)(tt) * kstep)
    Unit cur, nxt; int ui = 0;
    if (!S.next(0, cur)) return;
    f32x4 acc[2][2][4][2];
#pragma unroll
    for (int a = 0; a < 2; ++a)
#pragma unroll
        for (int b = 0; b < 2; ++b)
#pragma unroll
            for (int m = 0; m < 4; ++m)
#pragma unroll
                for (int n = 0; n < 2; ++n) acc[a][b][m][n] = (f32x4){0.f, 0.f, 0.f, 0.f};
    bf16x8 At[4][2], B0[2][2], B1[2][2];
    const char* cA = (const char*)g.A + (size_t)cur.pm * tstepA; const char* cB = (const char*)g.Bt + (size_t)cur.pn * tstepB;
    if constexpr (SP2) {
        PG8_STAGE(PG8_SB(0, 0), cB, voffB); PG8_STAGE(PG8_SB(0, 1), cB + hstepB, voffB); PG8_STAGE(PG8_SA(0, 0), cA, voffA); PG8_STAGE(PG8_SA(0, 1), cA + hstepA, voffA);
        if (wr == 1) PG8_BAR;
        PG8_WAIT_V(2); PG8_BAR;
        PG8_STAGE(PG8_SB(1, 0), cB + kstep, voffB); PG8_STAGE(PG8_SA(1, 0), cA + kstep, voffA); PG8_STAGE(PG8_SB(1, 1), cB + hstepB + kstep, voffB);
        PG8_WAIT_V(6); PG8_BAR;
    } else {
        PG8_STAGE(PG8_SB(0, 0), cB, voffB); PG8_STAGE(PG8_SA(0, 0), cA, voffA); PG8_STAGE(PG8_SB(0, 1), cB + hstepB, voffB); PG8_STAGE(PG8_SA(0, 1), cA + hstepA, voffA);
        if (wr == 1) PG8_BAR;
        PG8_WAIT_V(4); PG8_BAR;
        PG8_STAGE(PG8_SB(1, 0), cB + kstep, voffB); PG8_STAGE(PG8_SA(1, 0), cA + kstep, voffA); PG8_STAGE(PG8_SB(1, 1), cB + hstepB + kstep, voffB);
        PG8_WAIT_V(6); PG8_BAR;
    }
    for (;;) {
        const bool has_next = S.next(ui + 1, nxt);
        const char* nA = has_next ? (const char*)g.A + (size_t)nxt.pm * tstepA : cA; const char* nB = has_next ? (const char*)g.Bt + (size_t)nxt.pn * tstepB : cB;
        for (int t = 0; t < nt; t += 2) {
            const bool last = (t == nt - 2);
            if constexpr (Epi::HAS_MID) { if (t == nth) E.mid(acc, cur, wr, wc, fr, fq); }
            const char* a1 = PG8_AT(cA, t + 1);
            const char* a2 = last ? nA : PG8_AT(cA, t + 2); const char* b2 = last ? nB : cB + (size_t)(t + 2) * kstep;
            const char* a3 = last ? nA + kstep : PG8_AT(cA, t + 3); const char* b3 = b2 + kstep;
            if constexpr (SP2) {
            PG8_LDB(B0, 0, 0); PG8_LDB(B1, 0, 1); PG8_SCHED; PG8_LDA(At, 0, 0); PG8_STAGE(PG8_SA(1, 1), a1 + hstepA, voffA);
            PG8_WAIT_V(8); PG8_WAIT_L(0); PG8_BAR; PG8_MMA(0, 0, At, B0); PG8_MMA(0, 1, At, B1); PG8_BAR; PG8_SCHED;
            PG8_LDA(At, 0, 1); PG8_STAGE(PG8_SB(0, 0), b2, voffB); PG8_STAGE(PG8_SB(0, 1), b2 + hstepB, voffB); PG8_STAGE(PG8_SA(0, 0), a2, voffA);
            PG8_WAIT_V(8); PG8_WAIT_L(0); PG8_BAR; PG8_MMA(1, 0, At, B0); PG8_MMA(1, 1, At, B1); PG8_BAR; PG8_SCHED;
            PG8_LDB(B0, 1, 0); PG8_LDB(B1, 1, 1); PG8_SCHED; PG8_LDA(At, 1, 0); PG8_STAGE(PG8_SA(0, 1), a2 + hstepA, voffA);
            PG8_WAIT_V(8); PG8_WAIT_L(0); PG8_BAR; PG8_MMA(0, 0, At, B0); PG8_MMA(0, 1, At, B1); PG8_BAR; PG8_SCHED;
            PG8_LDA(At, 1, 1); PG8_STAGE(PG8_SB(1, 0), b3, voffB); PG8_STAGE(PG8_SB(1, 1), b3 + hstepB, voffB); PG8_STAGE(PG8_SA(1, 0), a3, voffA);
            PG8_WAIT_V(8); PG8_WAIT_L(0); PG8_BAR; PG8_MMA(1, 0, At, B0); PG8_MMA(1, 1, At, B1); PG8_BAR; PG8_SCHED;
            } else {
            PG8_LDB(B0, 0, 0); PG8_SCHED; PG8_LDA(At, 0, 0); PG8_STAGE(PG8_SA(1, 1), a1 + hstepA, voffA);
            PG8_WAIT_L(8); PG8_BAR; PG8_WAIT_L(0); PG8_MMA(0, 0, At, B0); PG8_BAR; PG8_SCHED;
            PG8_LDB(B1, 0, 1); PG8_STAGE(PG8_SB(0, 0), b2, voffB);
            PG8_BAR; PG8_WAIT_L(0); PG8_MMA(0, 1, At, B1); PG8_BAR;
            PG8_LDA(At, 0, 1); PG8_STAGE(PG8_SA(0, 0), a2, voffA);
            PG8_BAR; PG8_WAIT_L(0); PG8_MMA(1, 0, At, B0); PG8_BAR; PG8_SCHED;
            PG8_STAGE(PG8_SB(0, 1), b2 + hstepB, voffB);
            PG8_WAIT_V(6); PG8_BAR; PG8_MMA(1, 1, At, B1); PG8_BAR;
            PG8_LDB(B0, 1, 0); PG8_SCHED; PG8_LDA(At, 1, 0); PG8_STAGE(PG8_SA(0, 1), a2 + hstepA, voffA);
            PG8_WAIT_L(8); PG8_BAR; PG8_WAIT_L(0); PG8_MMA(0, 0, At, B0); PG8_BAR; PG8_SCHED;
            PG8_LDB(B1, 1, 1); PG8_STAGE(PG8_SB(1, 0), b3, voffB);
            PG8_BAR; PG8_WAIT_L(0); PG8_MMA(0, 1, At, B1); PG8_BAR;
            PG8_LDA(At, 1, 1); PG8_STAGE(PG8_SA(1, 0), a3, voffA);
            PG8_BAR; PG8_WAIT_L(0); PG8_MMA(1, 0, At, B0); PG8_BAR; PG8_SCHED;
            PG8_STAGE(PG8_SB(1, 1), b3 + hstepB, voffB);
            PG8_WAIT_V(6); PG8_BAR; PG8_MMA(1, 1, At, B1); PG8_BAR;
            }
        }
        if constexpr (ALIGN_EPI) { if (wr == 0) PG8_BAR; }
        E(acc, cur, wr, wc, fr, fq);
        if (!has_next) break;
#pragma unroll
        for (int a = 0; a < 2; ++a)
#pragma unroll
            for (int b = 0; b < 2; ++b)
#pragma unroll
                for (int m = 0; m < 4; ++m)
#pragma unroll
                    for (int n = 0; n < 2; ++n) acc[a][b][m][n] = (f32x4){0.f, 0.f, 0.f, 0.f};
        cur = nxt; cA = nA; cB = nB; ++ui;
        if constexpr (ALIGN_EPI) { if (wr == 1) PG8_BAR; }
    }
    PG8_WAIT_V(0);
    if constexpr (!ALIGN_EPI) { if (wr == 0) PG8_BAR; }
    PG8_BAR;
#undef PG8_SA
#undef PG8_SB
#undef PG8_STAGE
#undef PG8_LDA
#undef PG8_LDB
#undef PG8_MMA
#undef PG8_WAIT_V
#undef PG8_WAIT_L
#undef PG8_BAR
#undef PG8_SCHED
#undef PG8_AT
}
}
typedef unsigned short bf16;
typedef short bf16x8 __attribute__((ext_vector_type(8)));
typedef float f32x16 __attribute__((ext_vector_type(16)));
typedef float f32x4 __attribute__((ext_vector_type(4)));
typedef unsigned v4u __attribute__((ext_vector_type(4)));
typedef unsigned v2u __attribute__((ext_vector_type(2)));
#define GAS __attribute__((address_space(1)))
#define LAS __attribute__((address_space(3)))
typedef GAS unsigned gu32;
#define RLX_AGENT __ATOMIC_RELAXED, __HIP_MEMORY_SCOPE_AGENT
#define LDS_WAIT() asm volatile("s_waitcnt lgkmcnt(0)" ::: "memory")
#define VM_WAIT() asm volatile("s_waitcnt vmcnt(0)" ::: "memory")

constexpr int NWAVES = 8;
constexpr int BATCH = 8, SEQ = 2048, DM = 1024, M = BATCH * SEQ, PROJ = 8192;
constexpr size_t MiB = 1u << 20;
constexpr size_t WS_CTL = 0, CTL_ZERO_BYTES = 64 * 1024;
constexpr size_t WS_WCT = MiB / 4, WS_WOT = WS_WCT + 4 * MiB, WS_WGT = WS_WOT + 2 * MiB, WS_GS = WS_WGT + MiB / 2;
constexpr int GS_LD = 4104;
constexpr size_t WS_H3 = 15 * MiB + MiB / 2;
constexpr size_t WS_XN = 16 * MiB, WS_YHT = 16 * MiB, WS_WINT = 48 * MiB, WS_HT = 64 * MiB, WS_YH = 64 * MiB, WS_POOLED = 96 * MiB, WS_MGF = 96 * MiB,
                 WS_ZHT = 160 * MiB, WS_MG = 160 * MiB, WS_PL = 192 * MiB, WS_ZP = 224 * MiB, WS_END = 256 * MiB;
static_assert(WS_GS + (size_t)1024 * GS_LD * 2 <= WS_H3 && WS_ZP == WS_PL + (size_t)M * 1024 * 2, "ws map");
constexpr int CW_BAR = 1024;
constexpr int RING_OFF = 0, RING_BYTES = 131072;
constexpr int LDSCTL_OFF = 154624, MISC_OFF = LDSCTL_OFF + 320;
constexpr int LDS_BYTES = 155648;

__device__ __forceinline__ unsigned f2bf(float f) { unsigned u = __builtin_bit_cast(unsigned, f); return (u + 0x7fffu + ((u >> 16) & 1u)) >> 16; }
__device__ __forceinline__ unsigned pk2(float lo, float hi) { return f2bf(lo) | (f2bf(hi) << 16); }
__device__ __forceinline__ float bf2f(unsigned b) { return __builtin_bit_cast(float, b << 16); }
__device__ __forceinline__ float bflo(unsigned w) { return __builtin_bit_cast(float, w << 16); }
__device__ __forceinline__ float bfhi(unsigned w) { return __builtin_bit_cast(float, w & 0xffff0000u); }
__device__ __forceinline__ float silu_f(float v) { return v / (1.0f + __expf(-v)); }
__device__ __forceinline__ float sigm_f(float v) { return 1.0f / (1.0f + __expf(-v)); }
__device__ __forceinline__ float wave_sum(float v) {
#pragma unroll
    for (int o = 1; o < 64; o <<= 1) v += __shfl_xor(v, o);
    return v;
}

#define XB_TMO      128
#define XB_XCNT(j)  (256  + 64 * (j))
#define XB_XSUB(j)  (1280 + 64 * (j))
#define XB_XGEN(j)  (2304 + 64 * (j))
#define XB_TOP      3328
#define XB_TOPGEN   3392
#define XCD_BAR_WORDS 3456
#define XB_SPIN_CAP (1u << 18)
__device__ __forceinline__ unsigned xb_ld(unsigned* p)              { return __hip_atomic_load(p, __ATOMIC_RELAXED, __HIP_MEMORY_SCOPE_AGENT); }
__device__ __forceinline__ unsigned xb_add(unsigned* p, unsigned v) { return __hip_atomic_fetch_add(p, v, __ATOMIC_RELAXED, __HIP_MEMORY_SCOPE_AGENT); }
__device__ __forceinline__ unsigned xb_xcc_id() { return (unsigned)__builtin_amdgcn_s_getreg((3 << 11) | 20) & 0xFu; }
#define XB_SPIN(cond, bar) do { unsigned _sp = 0; while (cond) { __builtin_amdgcn_s_sleep(1); \
    if ((++_sp & 255u) == 0u) { if (xb_ld(&(bar)[XB_TMO])) break; if (_sp > XB_SPIN_CAP) { atomicAdd(&(bar)[XB_TMO], 1u); break; } } } } while (0)
struct XcdBarrier { unsigned* bar; unsigned x; volatile LAS unsigned* st; };
__device__ __forceinline__ XcdBarrier xcd_barrier_post(unsigned* bar, volatile LAS unsigned* st) {
    XcdBarrier b; b.bar = bar; b.x = xb_xcc_id(); b.st = st;
    if (threadIdx.x == 0) (void)xb_add(&bar[XB_XCNT(b.x)], 1u);
    return b;
}
__device__ __forceinline__ void xcd_barrier_complete(unsigned* bar, unsigned x, unsigned& nloc, unsigned& nx) {
    const unsigned G = gridDim.x * gridDim.y * gridDim.z;
    unsigned sum, cnt, mine, sp = 0u;
    for (;;) {
        sum = 0u; cnt = 0u; mine = 0u;
#pragma unroll
        for (unsigned j = 0; j < 16; ++j) { const unsigned c = xb_ld(&bar[XB_XCNT(j)]); sum += c; cnt += (c > 0u) ? 1u : 0u; mine = (j == x) ? c : mine; }
        if (sum == G) break;
        __builtin_amdgcn_s_sleep(1);
        if ((++sp & 255u) == 0u) { if (xb_ld(&bar[XB_TMO])) break; if (sp > XB_SPIN_CAP) { atomicAdd(&bar[XB_TMO], 1u); break; } }
    }
    nloc = mine > 0u ? mine : 1u; nx = cnt > 0u ? cnt : 1u;
}
__device__ __forceinline__ void xcd_barrier(const XcdBarrier& b) {
    asm volatile("s_waitcnt vmcnt(0)" ::: "memory");
    __syncthreads();
    if (threadIdx.x == 0) {
        unsigned* bar = b.bar;
        __builtin_amdgcn_s_waitcnt(0);
        unsigned nloc = b.st[0], nx = b.st[1];
        if (nloc == 0u) { xcd_barrier_complete(bar, b.x, nloc, nx); b.st[0] = nloc; b.st[1] = nx; }
        const unsigned old = xb_add(&bar[XB_XSUB(b.x)], 1u);
        const unsigned gen = old / nloc;
        if (old + 1u == (gen + 1u) * nloc) {
            __builtin_amdgcn_fence(__ATOMIC_RELEASE, "agent");
            asm volatile("s_waitcnt vmcnt(0)" ::: "memory");
            const unsigned og = xb_add(&bar[XB_TOP], 1u);
            const unsigned tg = og / nx;
            if (og + 1u == (tg + 1u) * nx) xb_add(&bar[XB_TOPGEN], 1u);
            else XB_SPIN(xb_ld(&bar[XB_TOPGEN]) == tg, bar);
            __builtin_amdgcn_fence(__ATOMIC_ACQUIRE, "agent");
            xb_add(&bar[XB_XGEN(b.x)], 1u);
            asm volatile("s_waitcnt vmcnt(0)" ::: "memory");
        } else {
            XB_SPIN(xb_ld(&bar[XB_XGEN(b.x)]) == gen, bar);
            __builtin_amdgcn_fence(__ATOMIC_ACQUIRE, "agent");
            asm volatile("s_waitcnt vmcnt(0)" ::: "memory");
        }
    }
    __syncthreads();
}
struct Args {
    const float *x, *g_norm, *w_in, *b_in, *conv_w, *conv_b, *fw1, *fb1, *fw2, *fb2, *fw3, *fb3, *fw4, *ffreq, *hyd, *w_ho, *pool_w, *pool_b, *pool_s, *w_po, *w_out, *g_fin;
    float* out; unsigned char* ws; int ph_lo, ph_hi, li, pad;
};
#define CAS __attribute__((address_space(4)))
template <class T> __device__ __forceinline__ const CAS T* as_const(const T* p) { return (const CAS T*)(unsigned long long)p; }

__device__ __forceinline__ void p0_transpose_item(const float* W, int K, int N, bf16* WT, int ldt, int koff, LAS float* scr, int item, int lane) {
    const int nblk = N / 32, kb = item / nblk, nb = item % nblk, k0 = 64 * kb, n0 = 32 * nb;
#pragma unroll 8
    for (int i = 0; i < 32; ++i) { const int kk = 2 * i + (lane >> 5); scr[kk * 33 + (lane & 31)] = W[(size_t)(k0 + kk) * N + n0 + (lane & 31)]; }
    LDS_WAIT(); asm volatile("" ::: "memory");
    const int c = lane & 7;
#pragma unroll
    for (int j = 0; j < 4; ++j) { const int n = (lane >> 3) + 8 * j; const LAS float* s = scr + (8 * c) * 33 + n;
        v4u o; o.x = pk2(s[0 * 33], s[1 * 33]); o.y = pk2(s[2 * 33], s[3 * 33]); o.z = pk2(s[4 * 33], s[5 * 33]); o.w = pk2(s[6 * 33], s[7 * 33]);
        *(GAS v4u*)(WT + (size_t)(n0 + n) * ldt + koff + k0 + 8 * c) = o; }
    LDS_WAIT(); asm volatile("" ::: "memory");
}
__device__ __forceinline__ void p0_xn_row(const float* xrow, const float* g, bf16* orow, int lane) {
    const GAS f32x4* xr = (const GAS f32x4*)xrow + lane;
    f32x4 v[4]; float s = 0.f;
#pragma unroll
    for (int j = 0; j < 4; ++j) { v[j] = xr[64 * j]; s += (v[j].x * v[j].x + v[j].y * v[j].y) + (v[j].z * v[j].z + v[j].w * v[j].w); }
    const float rstd = 1.0f / sqrtf(wave_sum(s) * (1.0f / DM) + 1e-6f);
    GAS unsigned long long* o8 = (GAS unsigned long long*)orow + lane;
#pragma unroll
    for (int j = 0; j < 4; ++j) { const f32x4 gg = ((const GAS f32x4*)g)[lane + 64 * j];
        o8[64 * j] = (unsigned long long)pk2(v[j].x * rstd * gg.x, v[j].y * rstd * gg.y) | ((unsigned long long)pk2(v[j].z * rstd * gg.z, v[j].w * rstd * gg.w) << 32); }
}
__device__ __forceinline__ void p0_h3_row(const Args& a, LAS float* scr, float* H3, int l, int lane) {
    float zz = 0.f;
    if (lane < 33) {
        if (lane == 0) zz = (float)l / (float)(SEQ - 1);
        else { const int i = (lane - 1) & 15; const float w = 6.283185307179586f * (float)l / (float)SEQ; const float f = 1e-4f + (float)i * ((15.0f - 1e-4f) / 15.0f);
               const float ang = w * f; zz = (lane <= 16) ? cosf(ang) : -sinf(ang); }
    }
    scr[lane] = zz;
    LDS_WAIT(); asm volatile("" ::: "memory");
    const float fr = a.ffreq[lane];
    float acc = a.fb1[lane];
    for (int i = 0; i < 33; ++i) acc += scr[i] * a.fw1[i * 64 + lane];
    scr[64 + lane] = sinf(fr * acc);
    LDS_WAIT(); asm volatile("" ::: "memory");
    acc = a.fb2[lane];
    for (int i = 0; i < 64; ++i) acc += scr[64 + i] * a.fw2[i * 64 + lane];
    scr[128 + lane] = sinf(fr * acc);
    LDS_WAIT(); asm volatile("" ::: "memory");
    acc = a.fb3[lane];
    for (int i = 0; i < 64; ++i) acc += scr[128 + i] * a.fw3[i * 64 + lane];
    H3[l * 64 + lane] = sinf(fr * acc);
    LDS_WAIT(); asm volatile("" ::: "memory");
}
__device__ __forceinline__ void p0_prologue(const Args& a, LAS unsigned char* lds, int gw, int NGW, int wave, int lane) {
    unsigned char* ws = a.ws;
    LAS float* scr = (LAS float*)(lds + RING_OFF + wave * 16384);
    float* H3 = (float*)(ws + WS_H3);
    for (int l = gw; l < SEQ; l += NGW) { int ln = lane; asm volatile("" : "+v"(ln)); p0_h3_row(a, scr, H3, l, ln); }
    constexpr int I_IN = (DM / 64) * (PROJ / 32), I_SQ = (DM / 64) * (DM / 32), I_PG = (256 / 64) * (256 / 32);
    constexpr int NITEMS = I_IN + 3 * I_SQ + 4 * I_PG;
    bf16 *WinT = (bf16*)(ws + WS_WINT), *WcT = (bf16*)(ws + WS_WCT), *WoT = (bf16*)(ws + WS_WOT), *WgT = (bf16*)(ws + WS_WGT);
    for (int it = gw; it < NITEMS; it += NGW) {
        int r = it;
        if (r < I_IN) { p0_transpose_item(a.w_in, DM, PROJ, WinT, DM, 0, scr, r, lane); continue; } r -= I_IN;
        if (r < I_SQ) { p0_transpose_item(a.w_ho, DM, DM, WcT, 2048, 0, scr, r, lane); continue; } r -= I_SQ;
        if (r < I_SQ) { p0_transpose_item(a.w_po, DM, DM, WcT, 2048, 1024, scr, r, lane); continue; } r -= I_SQ;
        if (r < I_SQ) { p0_transpose_item(a.w_out, DM, DM, WoT, DM, 0, scr, r, lane); continue; } r -= I_SQ;
        const int g = r / I_PG; p0_transpose_item(a.pool_w + (size_t)g * 65536, 256, 256, WgT + (size_t)g * 65536, 256, 0, scr, r % I_PG, lane);
    }
    bf16* XN = (bf16*)(ws + WS_XN);
    for (int m = gw; m < M; m += NGW) { int ln = lane; asm volatile("" : "+v"(ln)); p0_xn_row(a.x + (size_t)m * DM, a.g_norm, XN + (size_t)m * DM, ln); }
}
__device__ __forceinline__ void gs_item(const Args& a, const float* H3, bf16* Gs, int item, int lane) {
    const int pb = item & 31, cg = item >> 5, c0 = 16 * cg, j = 64 * pb + lane;
    float af[16], ab[16];
#pragma unroll
    for (int cc = 0; cc < 16; ++cc) { af[cc] = 0.f; ab[cc] = 0.f; }
    const CAS float* w4 = as_const(a.fw4) + c0;
    const GAS f32x4* hp = (const GAS f32x4*)(H3 + (size_t)j * 64);
#pragma unroll 1
    for (int i4 = 0; i4 < 16; ++i4) {
        const f32x4 hq = hp[i4];
        const CAS float* wr_ = w4 + i4 * 4 * 2048;
#pragma unroll
        for (int e = 0; e < 4; ++e) {
            const float hv = hq[e];
#pragma unroll
            for (int cc = 0; cc < 16; ++cc) { af[cc] += hv * wr_[e * 2048 + cc]; ab[cc] += hv * wr_[e * 2048 + 1024 + cc]; }
        }
    }
    const float MIN_DECAY = -3.0701134573253945f, MAX_DECAY = -15.350567286626973f;
    const float t = (float)j / (float)(SEQ - 1);
#pragma unroll
    for (int cc = 0; cc < 16; ++cc) {
        const int c = c0 + cc;
        const float delta = fabsf(MIN_DECAY + (float)c * ((MAX_DECAY - MIN_DECAY) / 1023.0f));
        const float dec = expf(-t * delta);
        bf16* row = Gs + (size_t)c * GS_LD + 8;
        if (j == 0) { row[2048] = (bf16)f2bf(af[cc] + ab[cc] + a.hyd[c]); }
        else { row[2048 - j] = (bf16)f2bf(af[cc] * dec); row[2048 + j] = (bf16)f2bf(ab[cc] * dec); }
        if (pb == 0 && lane < 9) row[(int)lane - 8] = 0;
    }
}

struct EpiP1N {
    static constexpr bool PERM = true, TRANS = false, HAS_MID = false;
    const float* bias; bf16 *PL, *GT; int pn_off;
    __device__ __forceinline__ void operator()(const pg8::f32x4 (&acc)[2][2][4][2], const pg8::Unit& u, int wr, int wc, int fr, int fq) const {
        const int pn = u.pn + pn_off;
        const bool isg = pn >= 24; const int act = pn < 20 ? 0 : (pn < 24 ? 1 : 2), ldc = isg ? 2048 : 1024, colt = (isg ? pn - 24 : (pn & 3)) * 256;
        bf16* base = isg ? GT : PL + (pn >= 20 ? (size_t)M * 1024 : (size_t)0);
        const int row0 = u.pm * 256 + wr * 64 + fr, col0 = colt + wc * 32 + 8 * fq, bcol0 = pn * 256 + wc * 32 + 8 * fq;
        pg8::f32x4 bv[2][2];
#pragma unroll
        for (int bj = 0; bj < 2; ++bj)
#pragma unroll
            for (int n = 0; n < 2; ++n) bv[bj][n] = *(const pg8::f32x4*)(bias + bcol0 + bj * 128 + 4 * n);
#pragma unroll
        for (int ai = 0; ai < 2; ++ai)
#pragma unroll
            for (int m = 0; m < 4; ++m) { bf16* rowp = base + (size_t)(row0 + ai * 128 + m * 16) * ldc + col0;
#pragma unroll
                for (int bj = 0; bj < 2; ++bj) { pg8::f32x4 v0 = acc[ai][bj][m][0] + bv[bj][0], v1 = acc[ai][bj][m][1] + bv[bj][1];
                    if (act != 0) {
#pragma unroll
                        for (int e = 0; e < 4; ++e) { const float s0 = __builtin_amdgcn_rcpf(1.0f + __expf(-v0[e])), s1 = __builtin_amdgcn_rcpf(1.0f + __expf(-v1[e]));
                            v0[e] = act == 1 ? v0[e] * s0 : s0; v1[e] = act == 1 ? v1[e] * s1 : s1; } }
                    pg8::u32x4 w; w.x = pg8::cvt_pk_bf16(v0[0], v0[1]); w.y = pg8::cvt_pk_bf16(v0[2], v0[3]); w.z = pg8::cvt_pk_bf16(v1[0], v1[1]); w.w = pg8::cvt_pk_bf16(v1[2], v1[3]);
                    *(pg8::u32x4*)(rowp + bj * 128) = w; }
                asm volatile("" ::: "memory"); }
    }
};
struct EpiP1T {
    static constexpr bool PERM = false, TRANS = true, HAS_MID = false;
    const float* bias; bf16 *HT, *ZHT;
    __device__ __forceinline__ void operator()(const pg8::f32x4 (&acc)[2][2][4][2], const pg8::Unit& u, int wr, int wc, int fr, int fq) const {
        const int pn = u.pn; const bool z = pn >= 12; bf16* base = z ? ZHT : HT;
        const int c0 = (z ? pn - 12 : pn) * 256 + wc * 32 + fr, bc0 = pn * 256 + wc * 32 + fr, r0 = u.pm * 256 + wr * 64 + 8 * fq;
#pragma unroll
        for (int bj = 0; bj < 2; ++bj)
#pragma unroll
            for (int n = 0; n < 2; ++n) {
                const float bv = bias[bc0 + bj * 128 + n * 16];
                bf16* colp = base + (size_t)(c0 + bj * 128 + n * 16) * M + r0;
#pragma unroll
                for (int ai = 0; ai < 2; ++ai)
#pragma unroll
                    for (int mp = 0; mp < 2; ++mp) { pg8::f32x4 v0 = acc[ai][bj][2 * mp][n] + bv, v1 = acc[ai][bj][2 * mp + 1][n] + bv;
                        if (z) {
#pragma unroll
                            for (int e = 0; e < 4; ++e) { v0[e] = v0[e] * __builtin_amdgcn_rcpf(1.0f + __expf(-v0[e])); v1[e] = v1[e] * __builtin_amdgcn_rcpf(1.0f + __expf(-v1[e])); } }
                        pg8::u32x4 w; w.x = pg8::cvt_pk_bf16(v0[0], v0[1]); w.y = pg8::cvt_pk_bf16(v0[2], v0[3]); w.z = pg8::cvt_pk_bf16(v1[0], v1[1]); w.w = pg8::cvt_pk_bf16(v1[2], v1[3]);
                        *(pg8::u32x4*)(colp + ai * 128 + mp * 32) = w; }
            }
    }
};
constexpr int CV_CS = 8256;
constexpr int CV_FC = 0;
constexpr int CV_RS = 4624;
constexpr int CV_U = 8 * CV_CS;
constexpr int CV_GATE = CV_U + 8 * CV_RS;
constexpr int CV_END = CV_GATE + 8 * 2048 * 2;
static_assert(CV_END <= LDSCTL_OFF, "conv LDS map");
struct __attribute__((packed, aligned(2))) U16B { v4u v; };

__device__ __forceinline__ void conv3_8(const v4u e, float lft, float rgt, float w0, float w1, float w2, float bb, float (&o)[8]) {
    float f[10]; f[0] = lft; f[9] = rgt;
    f[1] = bflo(e.x); f[2] = bfhi(e.x); f[3] = bflo(e.y); f[4] = bfhi(e.y); f[5] = bflo(e.z); f[6] = bfhi(e.z); f[7] = bflo(e.w); f[8] = bfhi(e.w);
#pragma unroll
    for (int j = 0; j < 8; ++j) o[j] = w0 * f[j] + w1 * f[j + 1] + w2 * f[j + 2] + bb;
}
struct ConvRaw { v4u e0[4], e1[4], e2[4], zz[4], gs[8]; unsigned hd0[4], hd1[4], hd2[4]; };
__device__ __forceinline__ void conv_load(const Args& a, int c, int tid, ConvRaw& R) {
    unsigned char* ws = a.ws;
    const bf16* HT = (const bf16*)(ws + WS_HT); const bf16* ZHT = (const bf16*)(ws + WS_ZHT); const bf16* Gs = (const bf16*)(ws + WS_GS);
    const bf16* h0 = HT + (size_t)c * M; const bf16* h1 = HT + (size_t)(1024 + c) * M; const bf16* h2 = HT + (size_t)(2048 + c) * M; const bf16* zp = ZHT + (size_t)c * M;
#pragma unroll
    for (int j = 0; j < 4; ++j) {
        const int q = tid + 512 * j, p0 = (q & 255) * 8, o = (q >> 8) * 2048 + p0;
        R.e0[j] = *(const GAS v4u*)(h0 + o); R.e1[j] = *(const GAS v4u*)(h1 + o); R.e2[j] = *(const GAS v4u*)(h2 + o); R.zz[j] = *(const GAS v4u*)(zp + o);
        const int lane = tid & 63;
        R.hd0[j] = 0u; R.hd1[j] = 0u; R.hd2[j] = 0u;
        if ((lane == 0 && p0 != 0) || (lane == 63 && p0 != 2040)) { const int oe = lane == 0 ? o - 1 : o + 8; R.hd0[j] = h0[oe]; R.hd1[j] = h1[oe]; R.hd2[j] = h2[oe]; }
    }
    const bf16* grow = Gs + (size_t)c * GS_LD + 8 + 8 * tid;
#pragma unroll
    for (int s = 0; s < 8; ++s) R.gs[s] = ((const U16B*)(grow - s))->v;
}
__device__ __forceinline__ void conv_process(const Args& a, LAS unsigned char* lds, int c, int tid, const ConvRaw& R) {
    const CAS float* cw = as_const(a.conv_w); const CAS float* cb = as_const(a.conv_b);
    const float w00 = cw[c], w01 = cw[3072 + c], w02 = cw[6144 + c], b0 = cb[c];
    const float w10 = cw[1024 + c], w11 = cw[3072 + 1024 + c], w12 = cw[6144 + 1024 + c], b1 = cb[1024 + c];
    const float w20 = cw[2048 + c], w21 = cw[3072 + 2048 + c], w22 = cw[6144 + 2048 + c], b2 = cb[2048 + c];
#pragma unroll
    for (int j = 0; j < 4; ++j) {
        const int q = tid + 512 * j, b = q >> 8, p0 = (q & 255) * 8, o = b * 2048 + p0;
        const int lane = tid & 63;
        const unsigned l0 = __shfl_up(R.e0[j].w >> 16, 1), l1 = __shfl_up(R.e1[j].w >> 16, 1), l2 = __shfl_up(R.e2[j].w >> 16, 1);
        const unsigned r0 = __shfl_down(R.e0[j].x & 0xffffu, 1), r1 = __shfl_down(R.e1[j].x & 0xffffu, 1), r2 = __shfl_down(R.e2[j].x & 0xffffu, 1);
        float x0[8], x1[8], vv[8];
        conv3_8(R.e0[j], bf2f(lane == 0 ? R.hd0[j] : l0), bf2f(lane == 63 ? R.hd0[j] : r0), w00, w01, w02, b0, x0);
        conv3_8(R.e1[j], bf2f(lane == 0 ? R.hd1[j] : l1), bf2f(lane == 63 ? R.hd1[j] : r1), w10, w11, w12, b1, x1);
        conv3_8(R.e2[j], bf2f(lane == 0 ? R.hd2[j] : l2), bf2f(lane == 63 ? R.hd2[j] : r2), w20, w21, w22, b2, vv);
        const v4u zz = R.zz[j];
        const float z[8] = {bflo(zz.x), bfhi(zz.x), bflo(zz.y), bfhi(zz.y), bflo(zz.z), bfhi(zz.z), bflo(zz.w), bfhi(zz.w)};
        v4u uo, go;
        uo.x = pk2(vv[0] * x1[0], vv[1] * x1[1]); uo.y = pk2(vv[2] * x1[2], vv[3] * x1[3]); uo.z = pk2(vv[4] * x1[4], vv[5] * x1[5]); uo.w = pk2(vv[6] * x1[6], vv[7] * x1[7]);
        go.x = pk2(x0[0] * z[0], x0[1] * z[1]); go.y = pk2(x0[2] * z[2], x0[3] * z[3]); go.z = pk2(x0[4] * z[4], x0[5] * z[5]); go.w = pk2(x0[6] * z[6], x0[7] * z[7]);
        *(LAS v4u*)(lds + CV_U + b * CV_RS + 192 + p0 * 2) = uo;
        *(LAS v4u*)(lds + CV_GATE + o * 2) = go;
    }
#pragma unroll
    for (int s = 0; s < 8; ++s) *(LAS v4u*)(lds + CV_FC + s * CV_CS + 16 * tid) = R.gs[s];
}
__device__ __forceinline__ void conv_mma(LAS unsigned char* lds, int wave, int lane) {
    const int r = lane & 31, h = lane >> 5, s = r & 7;
    f32x16 acc0, acc1;
#pragma unroll
    for (int i = 0; i < 16; ++i) { acc0[i] = 0.f; acc1[i] = 0.f; }
    {
        const LAS unsigned char* pa = lds + CV_FC + s * CV_CS + 2 * (8 * h - (r - s) + 2048) - 256 * (2 * wave);
        const LAS unsigned char* pb = lds + CV_U + (r >> 2) * CV_RS + 2 * (96 + 32 * (r & 3) + 8 * h);
        bf16x8 ring[8];
#pragma unroll
        for (int k = 0; k < 8; ++k) ring[k] = *(const LAS bf16x8*)(pa + 32 * (-14 + k));
#define CV_STEP(k, K0) { const bf16x8 Bf = *(const LAS bf16x8*)(pb + 32 * (K0)); const bf16x8 A0 = *(const LAS bf16x8*)(pa + 32 * (K0)); \
            acc0 = __builtin_amdgcn_mfma_f32_32x32x16_bf16(A0, Bf, acc0, 0, 0, 0); acc1 = __builtin_amdgcn_mfma_f32_32x32x16_bf16(ring[k], Bf, acc1, 0, 0, 0); ring[k] = A0; }
#pragma unroll 1
        for (int it = 0; it < 16; ++it) {
            const int K0 = -6 + 8 * it;
#pragma unroll
            for (int k = 0; k < 8; ++k) CV_STEP(k, K0 + k)
        }
#pragma unroll
        for (int k = 0; k < 6; ++k) CV_STEP(k, 122 + k)
#undef CV_STEP
    }
#pragma unroll
    for (int tt = 0; tt < 2; ++tt) {
        const int pos0 = 32 * (4 * (2 * wave + tt) + (r & 3)) + 4 * h;
#pragma unroll
        for (int g4 = 0; g4 < 4; ++g4) {
            LAS v2u* gp = (LAS v2u*)(lds + CV_GATE + ((r >> 2) * 2048 + pos0 + 8 * g4) * 2);
            const v2u gw = *gp; v2u o;
            const float y0 = tt ? acc1[4 * g4 + 0] : acc0[4 * g4 + 0], y1 = tt ? acc1[4 * g4 + 1] : acc0[4 * g4 + 1], y2 = tt ? acc1[4 * g4 + 2] : acc0[4 * g4 + 2], y3 = tt ? acc1[4 * g4 + 3] : acc0[4 * g4 + 3];
            o.x = pk2(y0 * bflo(gw.x), y1 * bfhi(gw.x)); o.y = pk2(y2 * bflo(gw.y), y3 * bfhi(gw.y));
            *gp = o;
        }
    }
}
__device__ __forceinline__ void conv_phase(const Args& a, LAS unsigned char* lds, int vcu, int G, int tid, int wave, int lane) {
    bf16* YHT = (bf16*)(a.ws + WS_YHT);
    if (tid < 192) { const int b = tid / 24, k = tid % 24; const int off = CV_U + b * CV_RS + (k < 12 ? k * 16 : 2 * (96 + 2048) + (k - 12) * 16); *(LAS v4u*)(lds + off) = (v4u){0u, 0u, 0u, 0u}; }
    ConvRaw R;
    int c = vcu;
    if (c < 1024) conv_load(a, c, tid, R);
    while (c < 1024) {
        conv_process(a, lds, c, tid, R);
        LDS_WAIT(); __syncthreads();
        const int cn = c + G;
        if (cn < 1024) conv_load(a, cn, tid, R);
        conv_mma(lds, wave, lane);
        LDS_WAIT(); __syncthreads();
        { bf16* yo = YHT + (size_t)c * M;
#pragma unroll
          for (int j = 0; j < 4; ++j) { const int q = tid + 512 * j; *(GAS v4u*)(yo + q * 8) = *(const LAS v4u*)(lds + CV_GATE + q * 16); } }
        LDS_WAIT(); __syncthreads();
        c = cn;
    }
}

constexpr int PU_XB = 0, PU_XROWS = 144;
constexpr int PU_P = PU_XROWS * 512, PU_RS = 528;
static_assert(PU_P + 128 * PU_RS <= LDSCTL_OFF, "pool LDS map");
__device__ __forceinline__ void pool_unit(const Args& a, LAS unsigned char* lds, int pm2, int g, int tid, int wave, int lane) {
    unsigned char* ws = a.ws;
    const bf16* PL = (const bf16*)(ws + WS_PL); bf16* YP = (bf16*)(ws + WS_ZP); const bf16* WgT = (const bf16*)(ws + WS_WGT) + (size_t)g * 65536;
    const int l0 = (pm2 & 15) * 128, m0 = pm2 * 128;
    {
        const bf16* src = PL + (size_t)(m0 - l0) * 1024 + 256 * g;
#pragma unroll
        for (int j = 0; j < 9; ++j) { const int q = tid + 512 * j, row = q >> 5, ch = q & 31, l = l0 - 8 + row;
            v4u v = (v4u){0u, 0u, 0u, 0u};
            if (l >= 0 && l < SEQ) v = *(const GAS v4u*)(src + (size_t)l * 1024 + 8 * ch);
            *(LAS v4u*)(lds + PU_XB + row * 512 + ch * 16) = v; }
    }
    LDS_WAIT(); __syncthreads();
    {
        const int cp = tid & 127, qr = tid >> 7, hw = 1 << g, rl = 32 * qr;
        const LAS unsigned* xc = (const LAS unsigned*)(lds + PU_XB + cp * 4);
        float s0 = 0.f, s1 = 0.f;
        for (int q = rl + 8 - hw; q < rl + 8 + hw; ++q) { const unsigned w = xc[q * 128]; s0 += bflo(w); s1 += bfhi(w); }
        LAS unsigned* pt = (LAS unsigned*)(lds + PU_P + cp * 4);
#pragma unroll 4
        for (int i = 0; i < 32; ++i) {
            const int rr = rl + i, l = l0 + rr;
            const float inv = 1.0f / (float)(min(l + hw, SEQ) - max(l - hw, 0));
            const unsigned wc_ = xc[(rr + 8) * 128], wn = xc[(rr + 8 + hw) * 128], wo = xc[(rr + 8 - hw) * 128];
            pt[rr * (PU_RS / 4)] = pk2(s0 * inv - bflo(wc_), s1 * inv - bfhi(wc_));
            s0 += bflo(wn) - bflo(wo); s1 += bfhi(wn) - bfhi(wo);
        }
    }
    LDS_WAIT(); __syncthreads();
    const int r = lane & 31, h = lane >> 5, wr = wave >> 1, wc = wave & 1;
    f32x16 acc[4];
#pragma unroll
    for (int ni = 0; ni < 4; ++ni)
#pragma unroll
        for (int i = 0; i < 16; ++i) acc[ni][i] = 0.f;
    {
        const LAS unsigned char* pa = lds + PU_P + (32 * wr + r) * PU_RS + 16 * h;
        const bf16* pb = WgT + (size_t)(128 * wc + r) * 256 + 8 * h;
#pragma unroll 4
        for (int kk = 0; kk < 16; ++kk) {
            const bf16x8 A = *(const LAS bf16x8*)(pa + kk * 32);
#pragma unroll
            for (int ni = 0; ni < 4; ++ni) { const bf16x8 B = *(const GAS bf16x8*)(pb + ni * 32 * 256 + kk * 16); acc[ni] = __builtin_amdgcn_mfma_f32_32x32x16_bf16(A, B, acc[ni], 0, 0, 0); }
        }
    }
    LDS_WAIT(); __syncthreads();
#pragma unroll
    for (int ni = 0; ni < 4; ++ni) {
        const int nn = 128 * wc + 32 * ni + r;
        const float pb_ = a.pool_b[256 * g + nn], ps_ = a.pool_s[256 * g + nn];
        LAS unsigned short* ot = (LAS unsigned short*)(lds + PU_P + (32 * wr + 4 * h) * PU_RS + nn * 2);
#pragma unroll
        for (int i = 0; i < 16; ++i) ot[((i & 3) + 8 * (i >> 2)) * (PU_RS / 2)] = (unsigned short)f2bf((acc[ni][i] + pb_) * ps_);
    }
    LDS_WAIT(); __syncthreads();
    {
        const int ch = tid & 31, rb = tid >> 5;
#pragma unroll
        for (int j = 0; j < 8; ++j) { const int row = rb + 16 * j;
            const v4u o = *(const LAS v4u*)(lds + PU_P + row * PU_RS + ch * 16);
            bf16* yp = YP + (size_t)(m0 + row) * 1024 + 256 * g + 8 * ch;
            const v4u z = *(const GAS v4u*)yp; v4u y;
            y.x = pk2(bflo(o.x) * bflo(z.x), bfhi(o.x) * bfhi(z.x)); y.y = pk2(bflo(o.y) * bflo(z.y), bfhi(o.y) * bfhi(z.y));
            y.z = pk2(bflo(o.z) * bflo(z.z), bfhi(o.z) * bfhi(z.z)); y.w = pk2(bflo(o.w) * bflo(z.w), bfhi(o.w) * bfhi(z.w));
            *(GAS v4u*)yp = y; }
    }
    LDS_WAIT(); __syncthreads();
}

constexpr int TR_RS = 260;
__device__ __forceinline__ void transpose_tile(const Args& a, LAS unsigned char* lds, int tile, int tid) {
    unsigned char* ws = a.ws;
    const bf16* YHT = (const bf16*)(ws + WS_YHT); bf16* YH = (bf16*)(ws + WS_YH);
    const int c0 = 64 * (tile & 15), m0 = 128 * (tile >> 4);
#pragma unroll
    for (int j = 0; j < 2; ++j) { const int q = tid + 512 * j, row = q >> 4, ch = q & 15;
        const v4u v = *(const GAS v4u*)(YHT + (size_t)(c0 + row) * M + m0 + 8 * ch);
        LAS unsigned* d = (LAS unsigned*)(lds + row * TR_RS + ch * 16); d[0] = v.x; d[1] = v.y; d[2] = v.z; d[3] = v.w; }
    LDS_WAIT(); __syncthreads();
#pragma unroll
    for (int j = 0; j < 2; ++j) { const int q = tid + 512 * j, mrow = q >> 3, cc8 = q & 7;
        const LAS unsigned short* s = (const LAS unsigned short*)(lds + (8 * cc8) * TR_RS + mrow * 2);
        v4u o;
        o.x = (unsigned)s[0 * (TR_RS / 2)] | ((unsigned)s[1 * (TR_RS / 2)] << 16); o.y = (unsigned)s[2 * (TR_RS / 2)] | ((unsigned)s[3 * (TR_RS / 2)] << 16);
        o.z = (unsigned)s[4 * (TR_RS / 2)] | ((unsigned)s[5 * (TR_RS / 2)] << 16); o.w = (unsigned)s[6 * (TR_RS / 2)] | ((unsigned)s[7 * (TR_RS / 2)] << 16);
        *(GAS v4u*)(YH + (size_t)(m0 + mrow) * 1024 + c0 + 8 * cc8) = o; }
    LDS_WAIT(); __syncthreads();
}

struct EpiMg {
    static constexpr bool PERM = true, TRANS = false, HAS_MID = true;
    const bf16* GT; bf16* MG;
    __device__ __forceinline__ void mid(pg8::f32x4 (&acc)[2][2][4][2], const pg8::Unit& u, int wr, int wc, int fr, int fq) const {
        const int row0 = u.pm * 256 + wr * 64 + fr, col0 = u.pn * 256 + wc * 32 + 8 * fq;
#pragma unroll
        for (int ai = 0; ai < 2; ++ai)
#pragma unroll
            for (int m = 0; m < 4; ++m) { const bf16* gp = GT + (size_t)(row0 + ai * 128 + m * 16) * 2048 + col0;
#pragma unroll
                for (int bj = 0; bj < 2; ++bj) { const v4u a0 = *(const GAS v4u*)(gp + bj * 128), a1 = *(const GAS v4u*)(gp + 1024 + bj * 128);
                    const float n0[8] = {bflo(a0.x), bfhi(a0.x), bflo(a0.y), bfhi(a0.y), bflo(a0.z), bfhi(a0.z), bflo(a0.w), bfhi(a0.w)};
                    const float d0[8] = {bflo(a1.x), bfhi(a1.x), bflo(a1.y), bfhi(a1.y), bflo(a1.z), bfhi(a1.z), bflo(a1.w), bfhi(a1.w)};
#pragma unroll
                    for (int e = 0; e < 4; ++e) { acc[ai][bj][m][0][e] *= n0[e] * __builtin_amdgcn_rcpf(d0[e]); acc[ai][bj][m][1][e] *= n0[4 + e] * __builtin_amdgcn_rcpf(d0[4 + e]); } }
                asm volatile("" ::: "memory"); }
    }
    __device__ __forceinline__ void operator()(const pg8::f32x4 (&acc)[2][2][4][2], const pg8::Unit& u, int wr, int wc, int fr, int fq) const {
        const int row0 = u.pm * 256 + wr * 64 + fr, col0 = u.pn * 256 + wc * 32 + 8 * fq;
#pragma unroll
        for (int ai = 0; ai < 2; ++ai)
#pragma unroll
            for (int m = 0; m < 4; ++m) { const size_t ro = (size_t)(row0 + ai * 128 + m * 16);
#pragma unroll
                for (int bj = 0; bj < 2; ++bj) { const v4u a1 = *(const GAS v4u*)(GT + ro * 2048 + 1024 + col0 + bj * 128);
                    const pg8::f32x4 v0 = acc[ai][bj][m][0], v1 = acc[ai][bj][m][1];
                    pg8::u32x4 w; w.x = pg8::cvt_pk_bf16(v0[0] * bflo(a1.x), v0[1] * bfhi(a1.x)); w.y = pg8::cvt_pk_bf16(v0[2] * bflo(a1.y), v0[3] * bfhi(a1.y));
                    w.z = pg8::cvt_pk_bf16(v1[0] * bflo(a1.z), v1[1] * bfhi(a1.z)); w.w = pg8::cvt_pk_bf16(v1[2] * bflo(a1.w), v1[3] * bfhi(a1.w));
                    *(pg8::u32x4*)(MG + ro * 1024 + col0 + bj * 128) = w; }
                asm volatile("" ::: "memory"); }
    }
};
struct EpiOutF {
    static constexpr bool PERM = false, TRANS = false, HAS_MID = false;
    const float* x; float* out;
    __device__ __forceinline__ void operator()(const pg8::f32x4 (&acc)[2][2][4][2], const pg8::Unit& u, int wr, int wc, int fr, int fq) const {
        const int row0 = u.pm * 256 + wr * 64 + fr, col0 = u.pn * 256 + wc * 32 + 4 * fq;
#pragma unroll
        for (int ai = 0; ai < 2; ++ai)
#pragma unroll
            for (int m = 0; m < 4; ++m) { const size_t off = (size_t)(row0 + ai * 128 + m * 16) * 1024 + col0;
#pragma unroll
                for (int bj = 0; bj < 2; ++bj)
#pragma unroll
                    for (int n = 0; n < 2; ++n) *(pg8::f32x4*)(out + off + bj * 128 + n * 16) = *(const pg8::f32x4*)(x + off + bj * 128 + n * 16) + acc[ai][bj][m][n];
                asm volatile("" ::: "memory"); }
    }
};
__device__ __forceinline__ void final_norm_row(float* row, const float* g, int lane) {
    GAS f32x4* xr = (GAS f32x4*)row + lane;
    f32x4 v[4]; float s = 0.f;
#pragma unroll
    for (int j = 0; j < 4; ++j) { v[j] = xr[64 * j]; s += (v[j].x * v[j].x + v[j].y * v[j].y) + (v[j].z * v[j].z + v[j].w * v[j].w); }
    const float rstd = 1.0f / sqrtf(wave_sum(s) * (1.0f / DM) + 1e-6f);
#pragma unroll
    for (int j = 0; j < 4; ++j) { const f32x4 gg = ((const GAS f32x4*)g)[lane + 64 * j]; xr[64 * j] = v[j] * rstd * gg; }
}

__global__ void k_transpose_b(const bf16* __restrict__ S, int R, int C, bf16* __restrict__ D) {
    __shared__ bf16 tile[32][34];
    const int c0 = blockIdx.x * 32, r0 = blockIdx.y * 32, tx = threadIdx.x, ty = threadIdx.y;
#pragma unroll
    for (int i = 0; i < 4; ++i) tile[ty + 8 * i][tx] = S[(size_t)(r0 + ty + 8 * i) * C + c0 + tx];
    __syncthreads();
#pragma unroll
    for (int i = 0; i < 4; ++i) D[(size_t)(c0 + ty + 8 * i) * R + r0 + tx] = tile[tx][ty + 8 * i];
}
template <class Epi>
__global__ __launch_bounds__(256) void k_gemm_simple(const bf16* __restrict__ A, int lda, size_t aoffz, const bf16* __restrict__ Bt, int ldb, size_t boffz, int K, Epi epi) {
    const int wave = threadIdx.x >> 6, lane = threadIdx.x & 63, r = lane & 31, h = lane >> 5;
    const int m0 = blockIdx.y * 64 + (wave >> 1) * 32, n0 = blockIdx.x * 64 + (wave & 1) * 32, z = blockIdx.z;
    const bf16* ap = A + aoffz * z + (size_t)(m0 + r) * lda + 8 * h;
    const bf16* bp = Bt + boffz * z + (size_t)(n0 + r) * ldb + 8 * h;
    f32x16 acc;
#pragma unroll
    for (int i = 0; i < 16; ++i) acc[i] = 0.f;
    for (int k0 = 0; k0 < K; k0 += 16) {
        const bf16x8 a = *(const bf16x8*)(ap + k0), b = *(const bf16x8*)(bp + k0);
        acc = __builtin_amdgcn_mfma_f32_32x32x16_bf16(a, b, acc, 0, 0, 0);
    }
#pragma unroll
    for (int i = 0; i < 16; ++i) epi(m0 + (i & 3) + 8 * (i >> 2) + 4 * h, n0 + r, z, acc[i]);
}
struct Epi1 { const float* b_in; bf16 *HT, *ZHT, *PL, *ZP, *GT;
    __device__ __forceinline__ void operator()(int m, int n, int, float v) const {
        v += b_in[n];
        if (n < 3072) HT[(size_t)n * M + m] = f2bf(v);
        else if (n < 4096) ZHT[(size_t)(n - 3072) * M + m] = f2bf(silu_f(v));
        else if (n < 5120) PL[(size_t)m * 1024 + (n - 4096)] = f2bf(v);
        else if (n < 6144) ZP[(size_t)m * 1024 + (n - 5120)] = f2bf(silu_f(v));
        else GT[(size_t)m * 2048 + (n - 6144)] = f2bf(sigm_f(v));
    } };
struct EpiPool { const float *pb, *ps; bf16* YP;
    __device__ __forceinline__ void operator()(int m, int n, int g, float v) const {
        const int nn = 256 * g + n; const size_t o = (size_t)m * 1024 + nn;
        YP[o] = f2bf((v + pb[nn]) * ps[nn] * bf2f(YP[o]));
    } };
struct EpiM1 { const bf16* GT; float* MGF;
    __device__ __forceinline__ void operator()(int m, int n, int, float v) const { MGF[(size_t)m * 1024 + n] = v * bf2f(GT[(size_t)m * 2048 + n]); } };
struct EpiM2 { const bf16* GT; const float* MGF; bf16* MG;
    __device__ __forceinline__ void operator()(int m, int n, int, float v) const { const size_t o = (size_t)m * 1024 + n; MG[o] = f2bf(MGF[o] + v * bf2f(GT[(size_t)m * 2048 + 1024 + n])); } };
struct EpiOut { const float* x; float* out;
    __device__ __forceinline__ void operator()(int m, int n, int, float v) const { const size_t o = (size_t)m * 1024 + n; out[o] = x[o] + v; } };

__global__ __launch_bounds__(256) void k_conv_naive(const bf16* __restrict__ HT, const bf16* __restrict__ ZHT, const bf16* __restrict__ Gs,
                                                    const float* __restrict__ cw, const float* __restrict__ cb, bf16* __restrict__ YHT) {
    __shared__ float g[4096];
    __shared__ float u[4][2048];
    const int c = blockIdx.x, bh = blockIdx.y, tid = threadIdx.x;
    for (int x = tid; x < 4096; x += 256) g[x] = bf2f(Gs[(size_t)c * GS_LD + 8 + x]);
    const float w10 = cw[0 * 3072 + 1024 + c], w11 = cw[1 * 3072 + 1024 + c], w12 = cw[2 * 3072 + 1024 + c], b1 = cb[1024 + c];
    const float w20 = cw[0 * 3072 + 2048 + c], w21 = cw[1 * 3072 + 2048 + c], w22 = cw[2 * 3072 + 2048 + c], b2 = cb[2048 + c];
    const float w00 = cw[0 * 3072 + c], w01 = cw[1 * 3072 + c], w02 = cw[2 * 3072 + c], b0 = cb[c];
    const bf16* h0 = HT + (size_t)c * M; const bf16* h1 = HT + (size_t)(1024 + c) * M; const bf16* h2 = HT + (size_t)(2048 + c) * M;
    for (int e = tid; e < 4 * 2048; e += 256) {
        const int b = e >> 11, l = e & 2047; const size_t o = (size_t)(bh * 4 + b) * 2048 + l;
        const float x1 = w10 * (l > 0 ? bf2f(h1[o - 1]) : 0.f) + w11 * bf2f(h1[o]) + w12 * (l < 2047 ? bf2f(h1[o + 1]) : 0.f) + b1;
        const float vv = w20 * (l > 0 ? bf2f(h2[o - 1]) : 0.f) + w21 * bf2f(h2[o]) + w22 * (l < 2047 ? bf2f(h2[o + 1]) : 0.f) + b2;
        u[b][l] = vv * x1;
    }
    __syncthreads();
    float acc[8][4];
#pragma unroll
    for (int ii = 0; ii < 8; ++ii)
#pragma unroll
        for (int b = 0; b < 4; ++b) acc[ii][b] = 0.f;
    for (int k = 0; k < 2048; ++k) {
        float uv[4];
#pragma unroll
        for (int b = 0; b < 4; ++b) uv[b] = u[b][k];
#pragma unroll
        for (int ii = 0; ii < 8; ++ii) { const float gv = g[k - (tid + 256 * ii) + 2048];
#pragma unroll
            for (int b = 0; b < 4; ++b) acc[ii][b] += gv * uv[b]; }
    }
#pragma unroll
    for (int ii = 0; ii < 8; ++ii)
#pragma unroll
        for (int b = 0; b < 4; ++b) {
            const int l = tid + 256 * ii; const size_t o = (size_t)(bh * 4 + b) * 2048 + l;
            const float x0 = w00 * (l > 0 ? bf2f(h0[o - 1]) : 0.f) + w01 * bf2f(h0[o]) + w02 * (l < 2047 ? bf2f(h0[o + 1]) : 0.f) + b0;
            YHT[(size_t)c * M + o] = f2bf(acc[ii][b] * x0 * bf2f(ZHT[(size_t)c * M + o]));
        }
}
__global__ __launch_bounds__(256) void k_pool_naive(const bf16* __restrict__ PL, bf16* __restrict__ P) {
    const size_t idx = (size_t)blockIdx.x * 256 + threadIdx.x; const int c = (int)(idx & 1023), m = (int)(idx >> 10), l = m & 2047, g = c >> 8, w = 2 << g;
    const int lo = max(l - w / 2, 0), hi = min(l + w / 2, SEQ);
    float s = 0.f;
    for (int q = lo; q < hi; ++q) s += bf2f(PL[(size_t)(m - l + q) * 1024 + c]);
    P[idx] = f2bf(s / (float)(hi - lo) - bf2f(PL[idx]));
}
__global__ __launch_bounds__(256) void k_final_norm(float* __restrict__ out, const float* __restrict__ g) {
    const int wave = threadIdx.x >> 6, lane = threadIdx.x & 63, row = blockIdx.x * 4 + wave;
    f32x4* xr = (f32x4*)(out + (size_t)row * DM) + lane;
    f32x4 v[4]; float s = 0.f;
#pragma unroll
    for (int j = 0; j < 4; ++j) { v[j] = xr[64 * j]; s += (v[j].x * v[j].x + v[j].y * v[j].y) + (v[j].z * v[j].z + v[j].w * v[j].w); }
    const float rstd = 1.0f / sqrtf(wave_sum(s) * (1.0f / DM) + 1e-6f);
#pragma unroll
    for (int j = 0; j < 4; ++j) { const f32x4 gg = ((const f32x4*)g)[lane + 64 * j]; xr[64 * j] = v[j] * rstd * gg; }
}

__global__ void __launch_bounds__(NWAVES * 64, 2) mega(Args a) {
    extern __shared__ __attribute__((aligned(16))) unsigned char lds_raw[];
    LAS unsigned char* lds = (LAS unsigned char*)lds_raw;
    const int tid = threadIdx.x, lane = tid & 63, wave = __builtin_amdgcn_readfirstlane(tid >> 6);
    const int G = gridDim.x, bx = blockIdx.x, vcu = (G % 8 == 0) ? (bx % 8) * (G / 8) + bx / 8 : bx;
    const int gw = vcu * NWAVES + wave, NGW = G * NWAVES;
    volatile LAS unsigned* MISC = (volatile LAS unsigned*)(lds + MISC_OFF);
    unsigned char* ws = a.ws;
    gu32* ctl = (gu32*)(ws + WS_CTL);
    for (int u = tid; u < (LDS_BYTES - LDSCTL_OFF) / 4; u += NWAVES * 64) ((LAS unsigned*)(lds + LDSCTL_OFF))[u] = 0u;
    __syncthreads();
    XcdBarrier bar = xcd_barrier_post((unsigned*)(ctl + CW_BAR) + a.li * XCD_BAR_WORDS, MISC + 8);
    const int lo = a.ph_lo, hi = a.ph_hi;
#define IN(k) (lo <= (k) && (k) < hi)
#define BOTH(k) (IN(k) && IN((k) + 1))
    bf16 *WcT = (bf16*)(ws + WS_WCT), *WoT = (bf16*)(ws + WS_WOT), *Gs = (bf16*)(ws + WS_GS), *XN = (bf16*)(ws + WS_XN),
         *WinT = (bf16*)(ws + WS_WINT), *HT = (bf16*)(ws + WS_HT), *YH = (bf16*)(ws + WS_YH), *ZHT = (bf16*)(ws + WS_ZHT), *MG = (bf16*)(ws + WS_MG),
         *PL = (bf16*)(ws + WS_PL), *ZP = (bf16*)(ws + WS_ZP), *GT = (bf16*)a.out;
    float* H3 = (float*)(ws + WS_H3);

    if (IN(0)) { p0_prologue(a, lds, gw, NGW, wave, lane); if (BOTH(0)) xcd_barrier(bar); }
    if (IN(1)) {
        for (int it = gw; it < 2048; it += NGW) gs_item(a, H3, Gs, it, lane);
        { pg8::Gemm g{XN, XN, WinT, DM, DM, M, 4096, DM, DM / 64}; pg8::StaticOrder S; S.init(M, 4096, G, bx);
          EpiP1T E{a.b_in, HT, ZHT};
          pg8::gemm_phase<EpiP1T, true, true, false>(lds + RING_OFF, g, S, E); }
        { pg8::Gemm g{XN, XN, WinT + (size_t)4096 * DM, DM, DM, M, 4096, DM, DM / 64}; pg8::StaticOrder S; S.init(M, 4096, G, bx);
          EpiP1N E{a.b_in, PL, GT, 16};
          pg8::gemm_phase<EpiP1N, true, true, false>(lds + RING_OFF, g, S, E); }
        if (BOTH(1)) xcd_barrier(bar);
    }
    if (IN(2)) {
        conv_phase(a, lds, vcu, G, tid, wave, lane);
        for (int un = vcu; un < 512; un += G) pool_unit(a, lds, un >> 2, un & 3, tid, wave, lane);
        if (BOTH(2)) xcd_barrier(bar);
    }
    if (IN(3)) {
        for (int t = vcu; t < 2048; t += G) transpose_tile(a, lds, t, tid);
        if (BOTH(3)) xcd_barrier(bar);
    }
    if (IN(4)) {
        pg8::Gemm g{YH, ZP, WcT, DM, 2048, M, DM, 2048, 16}; pg8::StaticOrder S; S.init(M, DM, G, bx);
        EpiMg E{GT, MG};
        pg8::gemm_phase<EpiMg, false, true, true>(lds + RING_OFF, g, S, E);
        if (BOTH(4)) xcd_barrier(bar);
    }
    if (IN(5)) {
        pg8::Gemm g{MG, MG, WoT, DM, DM, M, DM, DM, 16}; pg8::StaticOrder S; S.init(M, DM, G, bx);
        EpiOutF E{a.x, a.out};
        pg8::gemm_phase<EpiOutF, false, true, false>(lds + RING_OFF, g, S, E);
        if (BOTH(5)) xcd_barrier(bar);
    }
    if (IN(6)) {
        for (int m = gw; m < M; m += NGW) { int ln = lane; asm volatile("" : "+v"(ln)); final_norm_row(a.out + (size_t)m * DM, a.g_fin, ln); }
    }
#undef IN
#undef BOTH
}

#ifndef MEGA_PH
#define MEGA_PH 7
#endif
extern "C" void kernel_launch(void* const* d_in, const int* in_sizes, int n_in, void* d_out, int out_size, void* d_ws, size_t ws_size, hipStream_t stream) {
    static int grid = 0;
    if (grid == 0) {
        if (n_in != 22 || out_size != M * DM || ws_size < WS_END) { fprintf(stderr, "kernel_launch: unexpected shapes (n_in %d out %d ws %zu)\n", n_in, out_size, ws_size); grid = -1; return; }
        int dev = 0, cus = 0;
        if (hipGetDevice(&dev) != hipSuccess || hipDeviceGetAttribute(&cus, hipDeviceAttributeMultiprocessorCount, dev) != hipSuccess) { grid = -1; return; }
        if (hipFuncSetAttribute((const void*)mega, hipFuncAttributeMaxDynamicSharedMemorySize, LDS_BYTES) != hipSuccess) { fprintf(stderr, "kernel_launch: hipFuncSetAttribute failed\n"); grid = -1; return; }
        grid = cus;
    }
    if (grid < 0) return;
    unsigned char* ws = (unsigned char*)d_ws; float* out = (float*)d_out;
    (void)hipMemsetAsync(ws + WS_CTL, 0, CTL_ZERO_BYTES, stream);
    Args a{};
    a.x = (const float*)d_in[0]; a.g_norm = (const float*)d_in[1]; a.w_in = (const float*)d_in[2]; a.b_in = (const float*)d_in[3]; a.conv_w = (const float*)d_in[4]; a.conv_b = (const float*)d_in[5];
    a.fw1 = (const float*)d_in[6]; a.fb1 = (const float*)d_in[7]; a.fw2 = (const float*)d_in[8]; a.fb2 = (const float*)d_in[9]; a.fw3 = (const float*)d_in[10]; a.fb3 = (const float*)d_in[11];
    a.fw4 = (const float*)d_in[12]; a.ffreq = (const float*)d_in[13]; a.hyd = (const float*)d_in[14]; a.w_ho = (const float*)d_in[15]; a.pool_w = (const float*)d_in[16]; a.pool_b = (const float*)d_in[17];
    a.pool_s = (const float*)d_in[18]; a.w_po = (const float*)d_in[19]; a.w_out = (const float*)d_in[20]; a.g_fin = (const float*)d_in[21];
    a.out = out; a.ws = ws; a.ph_lo = 0; a.ph_hi = MEGA_PH; a.li = 0; a.pad = 0;
    hipLaunchKernelGGL(mega, dim3(grid), dim3(NWAVES * 64), LDS_BYTES, stream, a);
#if MEGA_PH < 7
    bf16 *WcT = (bf16*)(ws + WS_WCT), *WoT = (bf16*)(ws + WS_WOT), *WgT = (bf16*)(ws + WS_WGT), *Gs = (bf16*)(ws + WS_GS), *YHT = (bf16*)(ws + WS_YHT),
         *HT = (bf16*)(ws + WS_HT), *YH = (bf16*)(ws + WS_YH), *POOLED = (bf16*)(ws + WS_POOLED), *ZHT = (bf16*)(ws + WS_ZHT), *MG = (bf16*)(ws + WS_MG),
         *PL = (bf16*)(ws + WS_PL), *ZP = (bf16*)(ws + WS_ZP), *GT = (bf16*)d_out;
    float* MGF = (float*)(ws + WS_MGF);
    if (MEGA_PH < 3) { k_conv_naive<<<dim3(1024, 2), 256, 0, stream>>>(HT, ZHT, Gs, a.conv_w, a.conv_b, YHT); }
    if (MEGA_PH < 4) k_transpose_b<<<dim3(M / 32, 1024 / 32), dim3(32, 8), 0, stream>>>(YHT, 1024, M, YH);
    if (MEGA_PH < 3) { k_pool_naive<<<(unsigned)((size_t)M * 1024 / 256), 256, 0, stream>>>(PL, POOLED);
        k_gemm_simple<EpiPool><<<dim3(256 / 64, M / 64, 4), 256, 0, stream>>>(POOLED, 1024, 256, WgT, 256, 65536, 256, EpiPool{a.pool_b, a.pool_s, ZP}); }
    if (MEGA_PH < 5) { k_gemm_simple<EpiM1><<<dim3(DM / 64, M / 64, 1), 256, 0, stream>>>(YH, 1024, 0, WcT, 2048, 0, 1024, EpiM1{GT, MGF});
        k_gemm_simple<EpiM2><<<dim3(DM / 64, M / 64, 1), 256, 0, stream>>>(ZP, 1024, 0, WcT + 1024, 2048, 0, 1024, EpiM2{GT, MGF, MG}); }
    if (MEGA_PH < 6) k_gemm_simple<EpiOut><<<dim3(DM / 64, M / 64, 1), 256, 0, stream>>>(MG, 1024, 0, WoT, 1024, 0, 1024, EpiOut{a.x, out});
    if (MEGA_PH < 7) k_final_norm<<<M / 4, 256, 0, stream>>>(out, a.g_fin);
#endif
}
```
